# Optimizing an MI355X kernel written in HIP

```python
import jax, jax.numpy as jnp
from jax import lax
import numpy as np

D_MODEL = 4096
BATCH = 8
SEQ = 2048
DEPTH = 2

HEAD_DIM = 128
D_MIX = D_MODEL
N_MIXERS = 4
GROUP_WIDTH = D_MIX // N_MIXERS
N_HEADS = GROUP_WIDTH // HEAD_DIM

MOBA_BLOCK = 256
MOBA_TOPK = 3
MOBA_Q_CHUNK = 16

SGU_CHUNK = 128

Q_LORA_RANK = 768
KV_LORA_RANK = 256
QK_NOPE_DIM = 128
QK_ROPE_DIM = 64
V_HEAD_DIM = 128
ROPE_THETA = 10000.0

Q_BLOCK = 128

D_FF = 11008
CONV_WIDTH = 3

NORM_EPS = 1e-6
NEG_INF = -1e30

SPLIT_SIZES = (GROUP_WIDTH, GROUP_WIDTH, GROUP_WIDTH,
               GROUP_WIDTH, GROUP_WIDTH,
               Q_LORA_RANK, KV_LORA_RANK, QK_ROPE_DIM,
               GROUP_WIDTH, GROUP_WIDTH, GROUP_WIDTH, N_HEADS)
IN_COLS = sum(SPLIT_SIZES)

kernel_name = "hymba_style_moba_gmlp_mla_fox_convffn"


def split_points():
    return [int(s) for s in np.cumsum(SPLIT_SIZES)[:-1]]


def rmsnorm(x, g):
    xf = x.astype(jnp.float32)
    y = xf * lax.rsqrt(jnp.mean(xf * xf, axis=-1, keepdims=True) + NORM_EPS)
    return (y * g.astype(jnp.float32)).astype(x.dtype)


def layernorm(x, g, b):
    xf = x.astype(jnp.float32)
    xc = xf - jnp.mean(xf, axis=-1, keepdims=True)
    var = jnp.mean(xc * xc, axis=-1, keepdims=True)
    y = xc * lax.rsqrt(var + NORM_EPS) * g.astype(jnp.float32) + b.astype(jnp.float32)
    return y.astype(x.dtype)


def alibi_slopes(n):
    return jnp.exp2(-8.0 * jnp.arange(1, n + 1, dtype=jnp.float32) / n)


def apply_rope(x, pos):
    half = x.shape[-1] // 2
    inv_freq = ROPE_THETA ** (-jnp.arange(half, dtype=jnp.float32) / half)
    ang = pos.astype(jnp.float32)[:, None] * inv_freq[None, :]
    cos, sin = jnp.cos(ang), jnp.sin(ang)
    xf = x.astype(jnp.float32)
    x1, x2 = xf[..., :half], xf[..., half:]
    return jnp.concatenate([x1 * cos - x2 * sin, x2 * cos + x1 * sin], axis=-1).astype(x.dtype)


def to_heads(t, n_heads):
    b, s, w = t.shape
    return t.reshape(b, s, n_heads, w // n_heads).transpose(0, 2, 1, 3)


def merge_heads(t):
    b, h, s, d = t.shape
    return t.transpose(0, 2, 1, 3).reshape(b, s, h * d)


def causal_block_attention(q, k, v, scale, cum_log_f=None):
    S = q.shape[2]
    outs = []
    for i in range(S // Q_BLOCK):
        lo, hi = i * Q_BLOCK, (i + 1) * Q_BLOCK
        s = jnp.einsum("bhqd,bhkd->bhqk", q[:, :, lo:hi], k[:, :, :hi]).astype(jnp.float32) * scale
        if cum_log_f is not None:
            s = s + cum_log_f[:, :, lo:hi, None] - cum_log_f[:, :, None, :hi]
        t_pos = jnp.arange(lo, hi)[:, None]
        s_pos = jnp.arange(hi)[None, :]
        s = jnp.where(s_pos <= t_pos, s, NEG_INF)
        p = jax.nn.softmax(s, axis=-1).astype(v.dtype)
        outs.append(jnp.einsum("bhqk,bhkd->bhqd", p, v[:, :, :hi]))
    return jnp.concatenate(outs, axis=2)


def moba_attention(q, k, v, slopes):
    B, H, S, Dh = q.shape
    n_blk = -(-S // MOBA_BLOCK)
    pad = n_blk * MOBA_BLOCK - S
    k_blk = jnp.pad(k, ((0, 0), (0, 0), (0, pad), (0, 0))).reshape(B, H, n_blk, MOBA_BLOCK, Dh)
    v_blk = jnp.pad(v, ((0, 0), (0, 0), (0, pad), (0, 0))).reshape(B, H, n_blk, MOBA_BLOCK, Dh)
    k_mean = jnp.mean(k_blk.astype(jnp.float32), axis=3)
    top_k = min(MOBA_TOPK, max(n_blk - 1, 1))
    scale = Dh ** -0.5
    b_ix = jnp.arange(B)[:, None, None, None]
    h_ix = jnp.arange(H)[None, :, None, None]
    offs = jnp.arange(MOBA_BLOCK)
    m = slopes[None, :, None, None]

    def one_chunk(start):
        blk = start // MOBA_BLOCK
        q_c = lax.dynamic_slice_in_dim(q, start, MOBA_Q_CHUNK, axis=2)
        t = start + jnp.arange(MOBA_Q_CHUNK)
        k_own = lax.dynamic_index_in_dim(k_blk, blk, axis=2, keepdims=False)
        v_own = lax.dynamic_index_in_dim(v_blk, blk, axis=2, keepdims=False)
        own_pos = blk * MOBA_BLOCK + offs
        s_own = (jnp.einsum("bhqd,bhkd->bhqk", q_c, k_own).astype(jnp.float32) * scale
                 - m * jnp.abs(t[:, None] - own_pos[None, :]).astype(jnp.float32))
        s_own = jnp.where(own_pos[None, :] <= t[:, None], s_own, NEG_INF)
        gate = jnp.einsum("bhqd,bhnd->bhqn", q_c.astype(jnp.float32), k_mean)
        gate = jnp.where(jnp.arange(n_blk) < blk, gate, -jnp.inf)
        _, idx = lax.top_k(gate, top_k)
        k_sel = k_blk[b_ix, h_ix, idx]
        v_sel = v_blk[b_ix, h_ix, idx]
        sel_pos = idx[..., None] * MOBA_BLOCK + offs
        s_sel = (jnp.einsum("bhqd,bhqnkd->bhqnk", q_c, k_sel).astype(jnp.float32) * scale
                 - m[..., None] * jnp.abs(t[:, None, None] - sel_pos).astype(jnp.float32))
        s_sel = jnp.where((idx < blk)[..., None], s_sel, NEG_INF)
        logits = jnp.concatenate(
            [s_own, s_sel.reshape(B, H, MOBA_Q_CHUNK, top_k * MOBA_BLOCK)], axis=-1)
        p = jax.nn.softmax(logits, axis=-1).astype(v.dtype)
        p_own = p[..., :MOBA_BLOCK]
        p_sel = p[..., MOBA_BLOCK:].reshape(B, H, MOBA_Q_CHUNK, top_k, MOBA_BLOCK)
        return (jnp.einsum("bhqk,bhkd->bhqd", p_own, v_own)
                + jnp.einsum("bhqnk,bhqnkd->bhqd", p_sel, v_sel))

    starts = jnp.arange(S // MOBA_Q_CHUNK, dtype=jnp.int32) * MOBA_Q_CHUNK
    outs = lax.map(one_chunk, starts)
    return outs.transpose(1, 2, 0, 3, 4).reshape(B, H, S, Dh)


def chunked_spatial_gating(u, v, ln_g, ln_b, w_s, b_s):
    B, S, _ = v.shape
    vg = layernorm(v.reshape(B, S, N_HEADS, HEAD_DIM), ln_g, ln_b)
    vc = vg.reshape(B, S // SGU_CHUNK, SGU_CHUNK, N_HEADS, HEAD_DIM)
    causal = jnp.tril(jnp.ones((SGU_CHUNK, SGU_CHUNK), dtype=bool))
    w = jnp.where(causal[None], w_s, jnp.zeros_like(w_s))
    mixed = jnp.einsum("gts,bcsgd->bctgd", w, vc) + b_s.T[:, :, None]
    return u * mixed.reshape(B, S, N_HEADS * HEAD_DIM)


def latent_attention(c_q, c_kv, k_rope_raw, pos, q_norm_g, kv_norm_g, w_uq, w_ukv):
    B, S, _ = c_q.shape
    q = to_heads(rmsnorm(c_q, q_norm_g) @ w_uq, N_HEADS)
    q_nope, q_rope = q[..., :QK_NOPE_DIM], q[..., QK_NOPE_DIM:]
    kv = to_heads(rmsnorm(c_kv, kv_norm_g) @ w_ukv, N_HEADS)
    k_nope, v = kv[..., :QK_NOPE_DIM], kv[..., QK_NOPE_DIM:]
    q_rope = apply_rope(q_rope, pos)
    k_rope = apply_rope(k_rope_raw[:, None], pos)
    q_full = jnp.concatenate([q_nope, q_rope], axis=-1)
    k_full = jnp.concatenate(
        [k_nope, jnp.broadcast_to(k_rope, (B, N_HEADS, S, QK_ROPE_DIM))], axis=-1)
    return causal_block_attention(q_full, k_full, v, (QK_NOPE_DIM + QK_ROPE_DIM) ** -0.5)


def forgetting_attention(q, k, v, f_logit, b_f):
    log_f = jax.nn.log_sigmoid(f_logit.astype(jnp.float32) + b_f.astype(jnp.float32))
    cum = jnp.cumsum(log_f, axis=1).transpose(0, 2, 1)
    return causal_block_attention(to_heads(q, N_HEADS), to_heads(k, N_HEADS),
                                  to_heads(v, N_HEADS), HEAD_DIM ** -0.5, cum)


def causal_depthwise_conv(g, w, b):
    S = g.shape[1]
    gp = jnp.pad(g, ((0, 0), (CONV_WIDTH - 1, 0), (0, 0)))
    y = b
    for j in range(CONV_WIDTH):
        y = y + w[j] * gp[:, j:j + S]
    return y


def hybrid_layer(x, pos, slopes, norm_mix_g, w_in, sgu_ln_g, sgu_ln_b, sgu_w, sgu_b,
                 mla_q_norm_g, mla_kv_norm_g, mla_w_uq, mla_w_ukv, fox_b_f, group_norm_g,
                 w_o, norm_ffn_g, w_gate, w_val, conv_w, conv_b, w_down):
    h = rmsnorm(x, norm_mix_g)
    proj = h @ w_in
    (a_q, a_k, a_v, b_u, b_v, c_q, c_kv, c_kr,
     d_q, d_k, d_v, d_f) = jnp.split(proj, split_points(), axis=-1)
    y_a = merge_heads(moba_attention(to_heads(a_q, N_HEADS), to_heads(a_k, N_HEADS),
                                     to_heads(a_v, N_HEADS), slopes))
    y_b = chunked_spatial_gating(jax.nn.gelu(b_u), jax.nn.gelu(b_v),
                                 sgu_ln_g, sgu_ln_b, sgu_w, sgu_b)
    y_c = merge_heads(latent_attention(c_q, c_kv, c_kr, pos, mla_q_norm_g, mla_kv_norm_g,
                                       mla_w_uq, mla_w_ukv))
    y_d = merge_heads(forgetting_attention(d_q, d_k, d_v, d_f, fox_b_f))
    groups = [y_a, y_b, y_c, y_d]
    y = jnp.concatenate([rmsnorm(g, group_norm_g[i]) for i, g in enumerate(groups)], axis=-1)
    x = x + y @ w_o
    h = rmsnorm(x, norm_ffn_g)
    gate = causal_depthwise_conv(h @ w_gate, conv_w, conv_b)
    x = x + (jax.nn.silu(gate) * (h @ w_val)) @ w_down
    return x


def setup_inputs(seed: int = 0) -> dict:
    key = jax.random.key(seed)
    ks = jax.random.split(key, 24)
    f32 = jnp.float32

    def nrm(k, shape, scale):
        return jax.random.normal(k, shape, f32) * scale

    def gain(k, shape):
        return 1.0 + 0.02 * jax.random.normal(k, shape, f32)

    L = DEPTH
    return {
        "x": jax.random.normal(ks[0], (BATCH, SEQ, D_MODEL), f32),
        "norm_mix_g": gain(ks[1], (L, D_MODEL)),
        "w_in": nrm(ks[2], (L, D_MODEL, IN_COLS), D_MODEL ** -0.5),
        "sgu_ln_g": gain(ks[3], (L, N_HEADS, HEAD_DIM)),
        "sgu_ln_b": nrm(ks[4], (L, N_HEADS, HEAD_DIM), 0.02),
        "sgu_w": nrm(ks[5], (L, N_HEADS, SGU_CHUNK, SGU_CHUNK), SGU_CHUNK ** -0.5),
        "sgu_b": gain(ks[6], (L, N_HEADS, SGU_CHUNK)),
        "mla_q_norm_g": gain(ks[7], (L, Q_LORA_RANK)),
        "mla_kv_norm_g": gain(ks[8], (L, KV_LORA_RANK)),
        "mla_w_uq": nrm(ks[9], (L, Q_LORA_RANK, N_HEADS * (QK_NOPE_DIM + QK_ROPE_DIM)),
                        Q_LORA_RANK ** -0.5),
        "mla_w_ukv": nrm(ks[10], (L, KV_LORA_RANK, N_HEADS * (QK_NOPE_DIM + V_HEAD_DIM)),
                         KV_LORA_RANK ** -0.5),
        "fox_b_f": nrm(ks[11], (L, N_HEADS), 0.1),
        "group_norm_g": gain(ks[12], (L, N_MIXERS, GROUP_WIDTH)),
        "w_o": nrm(ks[13], (L, D_MIX, D_MODEL), D_MIX ** -0.5),
        "norm_ffn_g": gain(ks[14], (L, D_MODEL)),
        "w_gate": nrm(ks[15], (L, D_MODEL, D_FF), D_MODEL ** -0.5),
        "w_val": nrm(ks[16], (L, D_MODEL, D_FF), D_MODEL ** -0.5),
        "conv_w": nrm(ks[17], (L, CONV_WIDTH, D_FF), CONV_WIDTH ** -0.5),
        "conv_b": nrm(ks[18], (L, D_FF), 0.01),
        "w_down": nrm(ks[19], (L, D_FF, D_MODEL), D_FF ** -0.5),
        "final_norm_g": gain(ks[20], (D_MODEL,)),
    }


def reference(x, norm_mix_g, w_in, sgu_ln_g, sgu_ln_b, sgu_w, sgu_b, mla_q_norm_g,
              mla_kv_norm_g, mla_w_uq, mla_w_ukv, fox_b_f, group_norm_g, w_o, norm_ffn_g,
              w_gate, w_val, conv_w, conv_b, w_down, final_norm_g):
    pos = jnp.arange(x.shape[1])
    slopes = alibi_slopes(N_HEADS)
    for l in range(DEPTH):
        x = hybrid_layer(x, pos, slopes, norm_mix_g[l], w_in[l], sgu_ln_g[l], sgu_ln_b[l],
                         sgu_w[l], sgu_b[l], mla_q_norm_g[l], mla_kv_norm_g[l], mla_w_uq[l],
                         mla_w_ukv[l], fox_b_f[l], group_norm_g[l], w_o[l], norm_ffn_g[l],
                         w_gate[l], w_val[l], conv_w[l], conv_b[l], w_down[l])
    return rmsnorm(x, final_norm_g)
```

```cpp
#include <hip/hip_runtime.h>
#include <cstdio>
#include <cstdint>

#ifndef MK_MULTI
#define MK_MULTI 0
#endif

#define LAS __attribute__((address_space(3)))
#define GAS __attribute__((address_space(1)))
typedef unsigned short bf16;
typedef short bf16x8 __attribute__((ext_vector_type(8)));
typedef short s16x4 __attribute__((ext_vector_type(4)));
typedef float f32x2 __attribute__((ext_vector_type(2)));
typedef float f32x4 __attribute__((ext_vector_type(4)));
typedef float f32x16 __attribute__((ext_vector_type(16)));
typedef unsigned u32x2 __attribute__((ext_vector_type(2)));
typedef unsigned u32x4 __attribute__((ext_vector_type(4)));
typedef int i32x4 __attribute__((ext_vector_type(4)));
typedef int i32x8 __attribute__((ext_vector_type(8)));

constexpr int SEQ = 2048, NB = 8, M_TOK = NB * SEQ, DM = 4096, DFF = 11008, NGV = 2 * DFF, NINP = 9472  , NHEAD = 8;
constexpr float EPS = 1e-6f;
constexpr float L2E = 1.4426950408889634f;

__device__ __forceinline__ unsigned cvt_pk_bf16(float lo, float hi) { unsigned r; asm volatile("v_cvt_pk_bf16_f32 %0, %1, %2" : "=v"(r) : "v"(lo), "v"(hi)); return r; }
__device__ __forceinline__ float bf2f(unsigned short b) { return __uint_as_float(((unsigned)b) << 16); }
__device__ __forceinline__ unsigned short f2bf(float f) { unsigned u = __float_as_uint(f); return (unsigned short)((u + 0x7fffu + ((u >> 16) & 1u)) >> 16); }
__device__ __forceinline__ float wave_sum(float v) {
#pragma unroll
    for (int o = 1; o < 64; o <<= 1) v += __shfl_xor(v, o);
    return v;
}
__device__ __forceinline__ float gelu_tanh(float x) {
    const float t = x * x, u2 = x * (2.302208198f + 0.1029432327f * t);
    return x * __builtin_amdgcn_rcpf(1.0f + __builtin_amdgcn_exp2f(-u2));
}
typedef unsigned long long u64;
__device__ __forceinline__ void ssq_add(u64* p, float s) { atomicAdd(p, (u64)__float2ull_rz(s * 4294967296.0f)); }
__device__ __forceinline__ float ssq_get(const u64* p) { return __ull2float_rn(*p) * 2.3283064365386963e-10f; }
__device__ __forceinline__ unsigned pk4_fp8(float a, float b, float c, float d) {
    a = __builtin_amdgcn_fmed3f(a, -448.f, 448.f); b = __builtin_amdgcn_fmed3f(b, -448.f, 448.f); c = __builtin_amdgcn_fmed3f(c, -448.f, 448.f); d = __builtin_amdgcn_fmed3f(d, -448.f, 448.f);
    int p = __builtin_amdgcn_cvt_pk_fp8_f32(a, b, 0, false); p = __builtin_amdgcn_cvt_pk_fp8_f32(c, d, p, true); return (unsigned)p; }
#ifndef FP8_LAYERS
#define FP8_LAYERS 2
#endif
#ifndef FP8_FFN1
#define FP8_FFN1 2
#endif
constexpr float X_SCALE = 4.0f, WG_SCALE = 64.0f;
constexpr float ACT_SCALE = 4.0f, WD_SCALE = 128.0f;
__device__ __forceinline__ float silu_f(float x) { return x * __builtin_amdgcn_rcpf(1.0f + __builtin_amdgcn_exp2f(-x * L2E)); }

namespace pg8 {
typedef unsigned short bf16_t;
constexpr int BM = 256, BK = 64, HALF = 128, HTB = HALF * BK * 2, STAGE_BYTES = 8 * HTB, NXCD = 8, WGM = 8;
__host__ __device__ __forceinline__ int lds_byte(int r, int c) { const int st = (r >> 4) * 2 + (c >> 5), rr = r & 15, cc = c & 31, ob = rr * 64 + cc * 2; return st * 1024 + (ob ^ (((ob >> 9) & 1) << 5)); }
__host__ __device__ __forceinline__ void stage_rc(int b, int& R, int& C) { const int st = b / 1024, sb = b % 1024, swz = sb ^ (((sb >> 9) & 1) << 5); R = (st >> 1) * 16 + swz / 64; C = (st & 1) * 32 + (swz % 64) / 2; }
__host__ __device__ __forceinline__ int perm32(int rho) { const int n = rho >> 4, i = rho & 15; return 8 * (i >> 2) + 4 * n + (i & 3); }
struct Unit { int pm, pn; };
struct Gemm { const bf16_t* A; const bf16_t* Bt; int M, N, K, lda, ldb; int blockedA; };
struct StaticOrder {
    int nM, nN, nwg, G, c, wgm;
    __host__ __device__ void init(int M, int N, int G_, int c_, int wgm_ = WGM) { nM = M / BM; nN = N / BM; nwg = nM * nN; G = G_; c = c_; wgm = wgm_; }
    __host__ __device__ bool next(int i, Unit& u) const {
        const long L = (long)i * G + c; if (L >= nwg) return false;
        int wgid = (int)L; { const int q = nwg / NXCD, r = nwg % NXCD, xcd = wgid % NXCD, off = wgid / NXCD; wgid = (xcd < r ? xcd * (q + 1) : r * (q + 1) + (xcd - r) * q) + off; }
        const int nig = wgm * nN, gid = wgid / nig, fm = gid * wgm, gsz = (nM - fm) < wgm ? (nM - fm) : wgm;
        u.pm = fm + ((wgid % nig) % gsz); u.pn = (wgid % nig) / gsz; return true;
    }
    __device__ __forceinline__ void a_ready(const Unit&) const {}
    __device__ __forceinline__ void done(const Unit&) const {}
};

template <class Epi, class Sched, bool ALIGN_EPI = true, bool SP2 = true>
__device__ __forceinline__ void gemm_phase(LAS unsigned char* lds, const Gemm g, const Sched& S, const Epi& E) {
    int tid = threadIdx.x; asm volatile("" : "+v"(tid));
    const int wid = __builtin_amdgcn_readfirstlane(tid >> 6), lane = tid & 63, wr = wid >> 2, wc = wid & 3, fr = lane & 15, fq = lane >> 4;
    int K = g.K; asm volatile("" : "+s"(K));
    const int nt = K / BK;
    unsigned voffA[2], voffB[2];
#pragma unroll
    for (int i = 0; i < 2; ++i) { int R, C; stage_rc(tid * 16 + i * 8192, R, C); const int Rb = Epi::PERM ? ((R & ~31) + perm32(R & 31)) : R;
        voffA[i] = (unsigned)(R * g.lda + C) * 2u; voffB[i] = (unsigned)(Rb * g.ldb + C) * 2u; }
    const size_t kstep = (size_t)(BK * 2);
    const size_t kstepA = g.blockedA ? (size_t)(BM * BK * 2) : kstep;
    const size_t hstepA = (size_t)HALF * g.lda * 2, hstepB = (size_t)HALF * g.ldb * 2;
    const size_t tstepA = g.blockedA ? (size_t)nt * (BM * BK * 2) : 2 * hstepA, tstepB = 2 * hstepB;
    const unsigned ldsw = (unsigned)wid * 1024u;
    const int aoff = lds_byte(wr * 64 + fr, fq * 8), boff = lds_byte(wc * 32 + fr, fq * 8);
#define PG8_SA(b, h) (((b) * 2 + (h)) * HTB)
#define PG8_SB(b, h) ((4 + (b) * 2 + (h)) * HTB)
#define PG8_STAGE(bufoff, gbase, voff) do { _Pragma("unroll") for (int _i = 0; _i < 2; ++_i) \
        __builtin_amdgcn_global_load_lds((const unsigned*)((const char*)(gbase) + (voff)[_i]), (LAS unsigned*)(lds + (bufoff) + ldsw + _i * 8192), 16, 0, 0); } while (0)
#define PG8_LDA(dst, b, h) do { _Pragma("unroll") for (int m = 0; m < 4; ++m) _Pragma("unroll") for (int k = 0; k < 2; ++k) dst[m][k] = *(const LAS bf16x8*)(lds + PG8_SA(b, h) + aoff + m * 2048 + k * 1024); } while (0)
#define PG8_LDB(dst, b, h) do { _Pragma("unroll") for (int n = 0; n < 2; ++n) _Pragma("unroll") for (int k = 0; k < 2; ++k) dst[n][k] = *(const LAS bf16x8*)(lds + PG8_SB(b, h) + boff + n * 2048 + k * 1024); } while (0)
#define PG8_MMA(ai, bj, At, Bt) do { __builtin_amdgcn_s_setprio(1); \
        if constexpr (Epi::FP8) { _Pragma("unroll") for (int m = 0; m < 4; ++m) _Pragma("unroll") for (int n = 0; n < 2; ++n) { \
            const i32x8 b8 = __builtin_shufflevector(__builtin_bit_cast(i32x4, Bt[n][0]), __builtin_bit_cast(i32x4, Bt[n][1]), 0, 1, 2, 3, 4, 5, 6, 7); \
            const i32x8 a8 = __builtin_shufflevector(__builtin_bit_cast(i32x4, At[m][0]), __builtin_bit_cast(i32x4, At[m][1]), 0, 1, 2, 3, 4, 5, 6, 7); \
            asm volatile("v_mfma_scale_f32_16x16x128_f8f6f4 %0, %1, %2, %0, %3, %3 op_sel_hi:[0,0,0]" : "+v"(acc[ai][bj][m][n]) : "v"(b8), "v"(a8), "v"(mxs)); } } \
        else { _Pragma("unroll") for (int m = 0; m < 4; ++m) _Pragma("unroll") for (int n = 0; n < 2; ++n) _Pragma("unroll") for (int k = 0; k < 2; ++k) \
            acc[ai][bj][m][n] = __builtin_amdgcn_mfma_f32_16x16x32_bf16(Bt[n][k], At[m][k], acc[ai][bj][m][n], 0, 0, 0); } \
        __builtin_amdgcn_s_setprio(0); } while (0)
#define PG8_WAIT_V(n) asm volatile("s_waitcnt vmcnt(" #n ")" ::: "memory")
#define PG8_WAIT_L(n) asm volatile("s_waitcnt lgkmcnt(" #n ")" ::: "memory")
#define PG8_BAR __builtin_amdgcn_s_barrier()
#define PG8_SCHED __builtin_amdgcn_sched_barrier(0)
    Unit cur, nxt; int ui = 0;
    if (!S.next(0, cur)) return;
    int mxs = 0x7F7F7F7F; asm volatile("" : "+v"(mxs));
    f32x4 acc[2][2][4][2];
#pragma unroll
    for (int a = 0; a < 2; ++a)
#pragma unroll
        for (int b = 0; b < 2; ++b)
#pragma unroll
            for (int m = 0; m < 4; ++m)
#pragma unroll
                for (int n = 0; n < 2; ++n) acc[a][b][m][n] = (f32x4){0.f, 0.f, 0.f, 0.f};
    bf16x8 At[4][2], B0[2][2], B1[2][2];
    const char* cA = (const char*)g.A + (size_t)cur.pm * tstepA; const char* cB = (const char*)g.Bt + (size_t)cur.pn * tstepB;
    S.a_ready(cur);
    if constexpr (Epi::KHOOK) E.prep(cur, tid);
    if constexpr (SP2) {
        PG8_STAGE(PG8_SB(0, 0), cB, voffB); PG8_STAGE(PG8_SB(0, 1), cB + hstepB, voffB); PG8_STAGE(PG8_SA(0, 0), cA, voffA); PG8_STAGE(PG8_SA(0, 1), cA + hstepA, voffA);
        if (wr == 1) PG8_BAR;
        PG8_WAIT_V(2); PG8_BAR;
        PG8_STAGE(PG8_SB(1, 0), cB + kstep, voffB); PG8_STAGE(PG8_SA(1, 0), cA + kstepA, voffA); PG8_STAGE(PG8_SB(1, 1), cB + hstepB + kstep, voffB);
        PG8_WAIT_V(6); PG8_BAR;
    } else {
        PG8_STAGE(PG8_SB(0, 0), cB, voffB); PG8_STAGE(PG8_SA(0, 0), cA, voffA); PG8_STAGE(PG8_SB(0, 1), cB + hstepB, voffB); PG8_STAGE(PG8_SA(0, 1), cA + hstepA, voffA);
        if (wr == 1) PG8_BAR;
        PG8_WAIT_V(4); PG8_BAR;
        PG8_STAGE(PG8_SB(1, 0), cB + kstep, voffB); PG8_STAGE(PG8_SA(1, 0), cA + kstepA, voffA); PG8_STAGE(PG8_SB(1, 1), cB + hstepB + kstep, voffB);
        PG8_WAIT_V(6); PG8_BAR;
    }
    for (;;) {
        const bool has_next = S.next(ui + 1, nxt);
        const char* nA = has_next ? (const char*)g.A + (size_t)nxt.pm * tstepA : cA; const char* nB = has_next ? (const char*)g.Bt + (size_t)nxt.pn * tstepB : cB;
        if constexpr (Epi::KHOOK) {
#pragma unroll 1
        for (int tg = 0; tg < nt; tg += 16) {
            if (tg != 0) E.khook(acc, cur, tg, wr, fr);
            const int te = (tg + 16 < nt) ? tg + 16 : nt;
#pragma unroll 1
            for (int t = tg; t < te; t += 2) {
            const bool last = (t == nt - 2);
            const char* a1 = cA + (size_t)(t + 1) * kstepA;
            const char* a2 = last ? nA : cA + (size_t)(t + 2) * kstepA; const char* b2 = last ? nB : cB + (size_t)(t + 2) * kstep;
            const char* a3 = a2 + kstepA; const char* b3 = b2 + kstep;
            if (last && has_next) S.a_ready(nxt);
            if constexpr (SP2) {
            PG8_LDB(B0, 0, 0); PG8_LDB(B1, 0, 1); PG8_SCHED; PG8_LDA(At, 0, 0); PG8_STAGE(PG8_SA(1, 1), a1 + hstepA, voffA);
            PG8_WAIT_V(8); PG8_WAIT_L(0); PG8_BAR; PG8_MMA(0, 0, At, B0); PG8_MMA(0, 1, At, B1); PG8_BAR; PG8_SCHED;
            PG8_LDA(At, 0, 1); PG8_STAGE(PG8_SB(0, 0), b2, voffB); PG8_STAGE(PG8_SB(0, 1), b2 + hstepB, voffB); PG8_STAGE(PG8_SA(0, 0), a2, voffA);
            PG8_WAIT_V(8); PG8_WAIT_L(0); PG8_BAR; PG8_MMA(1, 0, At, B0); PG8_MMA(1, 1, At, B1); PG8_BAR; PG8_SCHED;
            PG8_LDB(B0, 1, 0); PG8_LDB(B1, 1, 1); PG8_SCHED; PG8_LDA(At, 1, 0); PG8_STAGE(PG8_SA(0, 1), a2 + hstepA, voffA);
            PG8_WAIT_V(8); PG8_WAIT_L(0); PG8_BAR; PG8_MMA(0, 0, At, B0); PG8_MMA(0, 1, At, B1); PG8_BAR; PG8_SCHED;
            PG8_LDA(At, 1, 1); PG8_STAGE(PG8_SB(1, 0), b3, voffB); PG8_STAGE(PG8_SB(1, 1), b3 + hstepB, voffB); PG8_STAGE(PG8_SA(1, 0), a3, voffA);
            PG8_WAIT_V(8); PG8_WAIT_L(0); PG8_BAR; PG8_MMA(1, 0, At, B0); PG8_MMA(1, 1, At, B1); PG8_BAR; PG8_SCHED;
            } else {
            PG8_LDB(B0, 0, 0); PG8_SCHED; PG8_LDA(At, 0, 0); PG8_STAGE(PG8_SA(1, 1), a1 + hstepA, voffA);
            PG8_WAIT_L(8); PG8_BAR; PG8_WAIT_L(0); PG8_MMA(0, 0, At, B0); PG8_BAR; PG8_SCHED;
            PG8_LDB(B1, 0, 1); PG8_STAGE(PG8_SB(0, 0), b2, voffB);
            PG8_BAR; PG8_WAIT_L(0); PG8_MMA(0, 1, At, B1); PG8_BAR;
            PG8_LDA(At, 0, 1); PG8_STAGE(PG8_SA(0, 0), a2, voffA);
            PG8_BAR; PG8_WAIT_L(0); PG8_MMA(1, 0, At, B0); PG8_BAR; PG8_SCHED;
            PG8_STAGE(PG8_SB(0, 1), b2 + hstepB, voffB);
            PG8_WAIT_V(6); PG8_BAR; PG8_MMA(1, 1, At, B1); PG8_BAR;
            PG8_LDB(B0, 1, 0); PG8_SCHED; PG8_LDA(At, 1, 0); PG8_STAGE(PG8_SA(0, 1), a2 + hstepA, voffA);
            PG8_WAIT_L(8); PG8_BAR; PG8_WAIT_L(0); PG8_MMA(0, 0, At, B0); PG8_BAR; PG8_SCHED;
            PG8_LDB(B1, 1, 1); PG8_STAGE(PG8_SB(1, 0), b3, voffB);
            PG8_BAR; PG8_WAIT_L(0); PG8_MMA(0, 1, At, B1); PG8_BAR;
            PG8_LDA(At, 1, 1); PG8_STAGE(PG8_SA(1, 0), a3, voffA);
            PG8_BAR; PG8_WAIT_L(0); PG8_MMA(1, 0, At, B0); PG8_BAR; PG8_SCHED;
            PG8_STAGE(PG8_SB(1, 1), b3 + hstepB, voffB);
            PG8_WAIT_V(6); PG8_BAR; PG8_MMA(1, 1, At, B1); PG8_BAR;
            }
            }
        }
        } else {
#pragma unroll 1
        for (int t = 0; t < nt; t += 2) {
            const bool last = (t == nt - 2);
            const char* a1 = cA + (size_t)(t + 1) * kstepA;
            const char* a2 = last ? nA : cA + (size_t)(t + 2) * kstepA; const char* b2 = last ? nB : cB + (size_t)(t + 2) * kstep;
            const char* a3 = a2 + kstepA; const char* b3 = b2 + kstep;
            if (last && has_next) S.a_ready(nxt);
            if constexpr (SP2) {
            PG8_LDB(B0, 0, 0); PG8_LDB(B1, 0, 1); PG8_SCHED; PG8_LDA(At, 0, 0); PG8_STAGE(PG8_SA(1, 1), a1 + hstepA, voffA);
            PG8_WAIT_V(8); PG8_WAIT_L(0); PG8_BAR; PG8_MMA(0, 0, At, B0); PG8_MMA(0, 1, At, B1); PG8_BAR; PG8_SCHED;
            PG8_LDA(At, 0, 1); PG8_STAGE(PG8_SB(0, 0), b2, voffB); PG8_STAGE(PG8_SB(0, 1), b2 + hstepB, voffB); PG8_STAGE(PG8_SA(0, 0), a2, voffA);
            PG8_WAIT_V(8); PG8_WAIT_L(0); PG8_BAR; PG8_MMA(1, 0, At, B0); PG8_MMA(1, 1, At, B1); PG8_BAR; PG8_SCHED;
            PG8_LDB(B0, 1, 0); PG8_LDB(B1, 1, 1); PG8_SCHED; PG8_LDA(At, 1, 0); PG8_STAGE(PG8_SA(0, 1), a2 + hstepA, voffA);
            PG8_WAIT_V(8); PG8_WAIT_L(0); PG8_BAR; PG8_MMA(0, 0, At, B0); PG8_MMA(0, 1, At, B1); PG8_BAR; PG8_SCHED;
            PG8_LDA(At, 1, 1); PG8_STAGE(PG8_SB(1, 0), b3, voffB); PG8_STAGE(PG8_SB(1, 1), b3 + hstepB, voffB); PG8_STAGE(PG8_SA(1, 0), a3, voffA);
            PG8_WAIT_V(8); PG8_WAIT_L(0); PG8_BAR; PG8_MMA(1, 0, At, B0); PG8_MMA(1, 1, At, B1); PG8_BAR; PG8_SCHED;
            } else {
            PG8_LDB(B0, 0, 0); PG8_SCHED; PG8_LDA(At, 0, 0); PG8_STAGE(PG8_SA(1, 1), a1 + hstepA, voffA);
            PG8_WAIT_L(8); PG8_BAR; PG8_WAIT_L(0); PG8_MMA(0, 0, At, B0); PG8_BAR; PG8_SCHED;
            PG8_LDB(B1, 0, 1); PG8_STAGE(PG8_SB(0, 0), b2, voffB);
            PG8_BAR; PG8_WAIT_L(0); PG8_MMA(0, 1, At, B1); PG8_BAR;
            PG8_LDA(At, 0, 1); PG8_STAGE(PG8_SA(0, 0), a2, voffA);
            PG8_BAR; PG8_WAIT_L(0); PG8_MMA(1, 0, At, B0); PG8_BAR; PG8_SCHED;
            PG8_STAGE(PG8_SB(0, 1), b2 + hstepB, voffB);
            PG8_WAIT_V(6); PG8_BAR; PG8_MMA(1, 1, At, B1); PG8_BAR;
            PG8_LDB(B0, 1, 0); PG8_SCHED; PG8_LDA(At, 1, 0); PG8_STAGE(PG8_SA(0, 1), a2 + hstepA, voffA);
            PG8_WAIT_L(8); PG8_BAR; PG8_WAIT_L(0); PG8_MMA(0, 0, At, B0); PG8_BAR; PG8_SCHED;
            PG8_LDB(B1, 1, 1); PG8_STAGE(PG8_SB(1, 0), b3, voffB);
            PG8_BAR; PG8_WAIT_L(0); PG8_MMA(0, 1, At, B1); PG8_BAR;
            PG8_LDA(At, 1, 1); PG8_STAGE(PG8_SA(1, 0), a3, voffA);
            PG8_BAR; PG8_WAIT_L(0); PG8_MMA(1, 0, At, B0); PG8_BAR; PG8_SCHED;
            PG8_STAGE(PG8_SB(1, 1), b3 + hstepB, voffB);
            PG8_WAIT_V(6); PG8_BAR; PG8_MMA(1, 1, At, B1); PG8_BAR;
            }
        }
        }
        if constexpr (ALIGN_EPI) { if (wr == 0) PG8_BAR; }
        if constexpr (Epi::FP8) asm volatile("s_nop 15\n\ts_nop 7" ::: "memory");
        E(acc, cur, wr, wc, fr, fq);
        if (!has_next) break;
#pragma unroll
        for (int a = 0; a < 2; ++a)
#pragma unroll
            for (int b = 0; b < 2; ++b)
#pragma unroll
                for (int m = 0; m < 4; ++m)
#pragma unroll
                    for (int n = 0; n < 2; ++n) acc[a][b][m][n] = (f32x4){0.f, 0.f, 0.f, 0.f};
        cur = nxt; cA = nA; cB = nB; ++ui;
        if constexpr (ALIGN_EPI) { if (wr == 1) PG8_BAR; }
    }
    PG8_WAIT_V(0);
    if constexpr (!ALIGN_EPI) { if (wr == 0) PG8_BAR; }
    PG8_BAR;
#undef PG8_SA
#undef PG8_SB
#undef PG8_STAGE
#undef PG8_LDA
#undef PG8_LDB
#undef PG8_MMA
#undef PG8_WAIT_V
#undef PG8_WAIT_L
#undef PG8_BAR
#undef PG8_SCHED
}
}
template <int SITE> struct EpiProj {
    static constexpr bool PERM = true, KHOOK = false, FP8 = false;
    bf16* O; int ldc; const u64* ssq_in; float inv_dim; u64* ssq_o1; u64* ssq_o2; const float* rope; float* flog;
    __device__ __forceinline__ void operator()(const f32x4 (&acc)[2][2][4][2], const pg8::Unit& u, int wr, int wc, int fr, int fq) const {
        int mode = 0;
        if (SITE == 0) { const int pn = u.pn; mode = (pn >= 12 && pn < 20) ? 1 : (pn >= 20 && pn < 23) ? 2 : (pn == 23) ? 3 : 0; }
        if (SITE == 1) mode = (u.pn >= 4) ? 4 : 0;
        const int row0 = u.pm * 256 + wr * 64 + fr, col0 = u.pn * 256 + wc * 32 + 8 * fq;
#pragma unroll
        for (int ai = 0; ai < 2; ++ai)
#pragma unroll
            for (int m = 0; m < 4; ++m) {
                const int row = row0 + ai * 128 + m * 16;
                const float rs = __builtin_amdgcn_rsqf(ssq_get(ssq_in + row) * inv_dim + EPS);
                f32x4 v0[2], v1[2];
#pragma unroll
                for (int bj = 0; bj < 2; ++bj) { v0[bj] = acc[ai][bj][m][0] * rs; v1[bj] = acc[ai][bj][m][1] * rs; }
                if (mode == 1) {
#pragma unroll
                    for (int bj = 0; bj < 2; ++bj)
#pragma unroll
                        for (int e = 0; e < 4; ++e) { v0[bj][e] = gelu_tanh(v0[bj][e]); v1[bj][e] = gelu_tanh(v1[bj][e]); }
                }
                if (mode == 2 || mode == 3) {
                    float s = 0.f;
#pragma unroll
                    for (int bj = 0; bj < 2; ++bj)
#pragma unroll
                        for (int e = 0; e < 4; ++e) s += v0[bj][e] * v0[bj][e] + v1[bj][e] * v1[bj][e];
                    s += __shfl_xor(s, 16); s += __shfl_xor(s, 32);
                    if (fq == 0) ssq_add((mode == 2 ? ssq_o1 : ssq_o2) + row, s);
                }
                if (mode == 4) {
                    const int pos = row & (SEQ - 1);
                    const float* rp = rope + (size_t)pos * 64 + 16 * (wc & 1) + 4 * fq;
                    const f32x4 cs = *(const f32x4*)rp, sn = *(const f32x4*)(rp + 32);
#pragma unroll
                    for (int bj = 0; bj < 2; ++bj) {
                        const f32x4 a = v0[bj], b = v1[bj]; v0[bj] = a * cs - b * sn; v1[bj] = b * cs + a * sn;
                    }
                }
                bf16* rowp = O + (size_t)row * ldc + col0;
#pragma unroll
                for (int bj = 0; bj < 2; ++bj) {
                    u32x4 w; w.x = cvt_pk_bf16(v0[bj][0], v0[bj][1]); w.y = cvt_pk_bf16(v0[bj][2], v0[bj][3]); w.z = cvt_pk_bf16(v1[bj][0], v1[bj][1]); w.w = cvt_pk_bf16(v1[bj][2], v1[bj][3]);
                    *(u32x4*)(rowp + bj * 128) = w; }
            }
    }
};
struct EpiPart {
    static constexpr bool PERM = true, KHOOK = false, FP8 = false;
    float* part;
    __device__ __forceinline__ void operator()(const f32x4 (&acc)[2][2][4][2], const pg8::Unit& u, int wr, int wc, int fr, int fq) const {
        if (wc < 2 || (wc == 2 && fq == 0)) {
            const int row0 = u.pm * 256 + wr * 64 + fr, c0 = wc * 32 + 8 * fq;
#pragma unroll
            for (int ai = 0; ai < 2; ++ai)
#pragma unroll
                for (int m = 0; m < 4; ++m) { float* p = part + (size_t)(row0 + ai * 128 + m * 16) * 72 + c0;
                    *(f32x4*)p = acc[ai][0][m][0]; *(f32x4*)(p + 4) = acc[ai][0][m][1]; }
        }
    }
};
struct EpiNull { static constexpr bool PERM = true, KHOOK = false, FP8 = false; float* sink;
    __device__ __forceinline__ void operator()(const f32x4 (&acc)[2][2][4][2], const pg8::Unit& u, int wr, int wc, int fr, int fq) const {
        f32x4 s = acc[0][0][0][0];
#pragma unroll
        for (int ai = 0; ai < 2; ++ai)
#pragma unroll
            for (int bj = 0; bj < 2; ++bj)
#pragma unroll
                for (int m = 0; m < 4; ++m)
#pragma unroll
                    for (int n = 0; n < 2; ++n) s = s + acc[ai][bj][m][n];
        if (s[0] + s[1] + s[2] + s[3] == 12345.678f) sink[0] = 1.f; } };
struct OneUnit { int pm, pn;
    __device__ __forceinline__ bool next(int i, pg8::Unit& u) const { if (i != 0) return false; u.pm = pm; u.pn = pn; return true; }
    __device__ __forceinline__ void a_ready(const pg8::Unit&) const {}
    __device__ __forceinline__ void done(const pg8::Unit&) const {} };
template <bool F32IN, bool GNORM, bool F8 = false> struct EpiResid {
    static constexpr bool PERM = true, KHOOK = GNORM, FP8 = F8;
    const float* resid32; bf16* xb; u64* ssq; const u64* ssqy; LAS float* tbl; unsigned char* xb8;
    __device__ __forceinline__ void prep(const pg8::Unit& u, int tid) const {
        if (tid < 256) { const u64* sp = ssqy + (size_t)(u.pm * 256 + tid) * 4; float r[4];
#pragma unroll
            for (int g = 0; g < 4; ++g) r[g] = __builtin_amdgcn_rsqf(ssq_get(sp + g) * (1.0f / 1024.0f) + EPS);
            *(LAS f32x4*)(tbl + tid * 4) = (f32x4){r[0] * __builtin_amdgcn_rcpf(r[1]), r[1] * __builtin_amdgcn_rcpf(r[2]), r[2] * __builtin_amdgcn_rcpf(r[3]), r[3]}; }
        asm volatile("s_waitcnt lgkmcnt(0)" ::: "memory");
    }
    __device__ __forceinline__ void khook(f32x4 (&acc)[2][2][4][2], const pg8::Unit& u, int t, int wr, int fr) const {
        const int g = t >> 4, rl0 = wr * 64 + fr;
#pragma unroll
        for (int ai = 0; ai < 2; ++ai)
#pragma unroll
            for (int m = 0; m < 4; ++m) { const float ratio = tbl[(rl0 + ai * 128 + m * 16) * 4 + g - 1];
#pragma unroll
                for (int bj = 0; bj < 2; ++bj)
#pragma unroll
                    for (int n = 0; n < 2; ++n) acc[ai][bj][m][n] = acc[ai][bj][m][n] * ratio; }
    }
    __device__ __forceinline__ void operator()(const f32x4 (&acc)[2][2][4][2], const pg8::Unit& u, int wr, int wc, int fr, int fq) const {
        asm volatile("" : "+v"(fr), "+v"(fq));
        const int row0 = u.pm * 256 + wr * 64 + fr, col0 = u.pn * 256 + wc * 32 + 8 * fq;
        f32x4 rb[3][4];
#define ER_LOAD(k) do { const size_t off_ = (size_t)(row0 + ((k) >> 2) * 128 + ((k) & 3) * 16) * DM + col0; \
        if constexpr (F32IN) { rb[(k) % 3][0] = *(const f32x4*)(resid32 + off_); rb[(k) % 3][1] = *(const f32x4*)(resid32 + off_ + 4); rb[(k) % 3][2] = *(const f32x4*)(resid32 + off_ + 128); rb[(k) % 3][3] = *(const f32x4*)(resid32 + off_ + 132); } \
        else { _Pragma("unroll") for (int b_ = 0; b_ < 2; ++b_) { const u32x4 t_ = *(const u32x4*)(xb + off_ + b_ * 128); \
                 rb[(k) % 3][2 * b_] = (f32x4){__uint_as_float(t_.x << 16), __uint_as_float(t_.x & 0xffff0000u), __uint_as_float(t_.y << 16), __uint_as_float(t_.y & 0xffff0000u)}; \
                 rb[(k) % 3][2 * b_ + 1] = (f32x4){__uint_as_float(t_.z << 16), __uint_as_float(t_.z & 0xffff0000u), __uint_as_float(t_.w << 16), __uint_as_float(t_.w & 0xffff0000u)}; } } } while (0)
        ER_LOAD(0); ER_LOAD(1);
#pragma unroll
        for (int k = 0; k < 8; ++k) {
            const int ai = k >> 2, m = k & 3;
            if (k + 2 < 8) ER_LOAD(k + 2);
            const int row = row0 + ai * 128 + m * 16; const size_t off = (size_t)row * DM + col0; float s = 0.f;
            const float r3 = GNORM ? tbl[(wr * 64 + fr + ai * 128 + m * 16) * 4 + 3] : (F8 ? 1.0f / (ACT_SCALE * WD_SCALE) : 1.0f);
#pragma unroll
            for (int bj = 0; bj < 2; ++bj) {
                const f32x4 v0 = rb[k % 3][bj * 2] + acc[ai][bj][m][0] * r3, v1 = rb[k % 3][bj * 2 + 1] + acc[ai][bj][m][1] * r3;
                u32x4 w; w.x = cvt_pk_bf16(v0[0], v0[1]); w.y = cvt_pk_bf16(v0[2], v0[3]); w.z = cvt_pk_bf16(v1[0], v1[1]); w.w = cvt_pk_bf16(v1[2], v1[3]);
                *(u32x4*)(xb + off + bj * 128) = w;
                if (xb8) { u32x2 q; q.x = pk4_fp8(v0[0] * X_SCALE, v0[1] * X_SCALE, v0[2] * X_SCALE, v0[3] * X_SCALE); q.y = pk4_fp8(v1[0] * X_SCALE, v1[1] * X_SCALE, v1[2] * X_SCALE, v1[3] * X_SCALE);
                    *(u32x2*)(xb8 + off + bj * 128) = q; }
                s += ((v0[0] * v0[0] + v0[1] * v0[1]) + (v0[2] * v0[2] + v0[3] * v0[3])) + ((v1[0] * v1[0] + v1[1] * v1[1]) + (v1[2] * v1[2] + v1[3] * v1[3]));
            }
            s += __shfl_xor(s, 16); s += __shfl_xor(s, 32);
            if (fq == 0) ssq_add(ssq + row, s);
            __builtin_amdgcn_sched_barrier(0);
        }
#undef ER_LOAD
    }
};
__device__ __forceinline__ float dpp_ror1(float v) { return __builtin_bit_cast(float, __builtin_amdgcn_update_dpp(0, __builtin_bit_cast(int, v), 0x121, 0xF, 0xF, false)); }
__device__ __forceinline__ float dpp_ror2(float v) { return __builtin_bit_cast(float, __builtin_amdgcn_update_dpp(0, __builtin_bit_cast(int, v), 0x122, 0xF, 0xF, false)); }
template <bool F8, bool F8IN = false>
struct EpiFfn1 {
    static constexpr bool PERM = true, KHOOK = false, FP8 = F8IN;
    static constexpr float QS = F8IN ? 1.0f / (X_SCALE * WG_SCALE) : 1.0f;
    bf16* act; const u64* ssq_in; const float* cw; const float* cb; float* side; LAS float* xch;
    __device__ __forceinline__ void operator()(const f32x4 (&acc)[2][2][4][2], const pg8::Unit& u, int wr, int wc, int fr, int fq) const {
        asm volatile("" : "+v"(fr), "+v"(fq));
        const int wid = wr * 4 + wc;
        const int row0 = u.pm * 256 + wr * 64 + fr, ch0 = u.pn * 128 + wc * 32 + 8 * fq;
        f32x4 w0[2], w1[2], w2[2], bb[2];
#pragma unroll
        for (int n = 0; n < 2; ++n) { w0[n] = *(const f32x4*)(cw + ch0 + 4 * n); w1[n] = *(const f32x4*)(cw + DFF + ch0 + 4 * n); w2[n] = *(const f32x4*)(cw + 2 * DFF + ch0 + 4 * n); bb[n] = *(const f32x4*)(cb + ch0 + 4 * n); }
        if (fr >= 14) {
#pragma unroll
            for (int ai = 0; ai < 2; ++ai) {
                const float rs = __builtin_amdgcn_rsqf(ssq_get(ssq_in + row0 + ai * 128 + 48) * (1.0f / DM) + EPS) * QS;
                LAS float* xp = xch + ((wid * 2 + ai) * 2 + (fr - 14)) * 32 + 8 * fq;
                *(LAS f32x4*)xp = acc[ai][0][3][0] * rs; *(LAS f32x4*)(xp + 4) = acc[ai][0][3][1] * rs;
            }
        }
        asm volatile("s_waitcnt lgkmcnt(0)" ::: "memory"); __builtin_amdgcn_s_barrier(); asm volatile("" ::: "memory");
#pragma unroll
        for (int ai = 0; ai < 2; ++ai) {
            f32x4 xa[2], xb_[2];
            const bool have = (wr == 1) || (ai == 1);
            { const int sw = (wr == 1) ? wc : 4 + wc, sai = (wr == 1) ? ai : 0;
              const LAS float* xp = xch + ((sw * 2 + sai) * 2) * 32 + 8 * fq;
#pragma unroll
              for (int n = 0; n < 2; ++n) { xa[n] = have ? *(const LAS f32x4*)(xp + 4 * n) : (f32x4){0.f, 0.f, 0.f, 0.f}; xb_[n] = have ? *(const LAS f32x4*)(xp + 32 + 4 * n) : (f32x4){0.f, 0.f, 0.f, 0.f}; } }
            f32x4 gprev[2];
#pragma unroll
            for (int m = 0; m < 4; ++m) {
                const int row = row0 + ai * 128 + m * 16;
                const float rs = __builtin_amdgcn_rsqf(ssq_get(ssq_in + row) * (1.0f / DM) + EPS) * QS;
                f32x4 g[2], vv[2], o[2];
#pragma unroll
                for (int n = 0; n < 2; ++n) { g[n] = acc[ai][0][m][n] * rs; vv[n] = acc[ai][1][m][n] * rs; }
#pragma unroll
                for (int n = 0; n < 2; ++n)
#pragma unroll
                    for (int e = 0; e < 4; ++e) {
                        const float gp = (m == 0) ? ((fr == 14) ? xa[n][e] : xb_[n][e]) : gprev[n][e];
                        const float p1 = dpp_ror1((fr == 15) ? gp : g[n][e]), p2 = dpp_ror2((fr >= 14) ? gp : g[n][e]);
                        const float gate = bb[n][e] + w0[n][e] * p2 + w1[n][e] * p1 + w2[n][e] * g[n][e];
                        o[n][e] = silu_f(gate) * vv[n][e];
                    }
                if constexpr (F8) {
                u32x2 w; w.x = pk4_fp8(o[0][0] * ACT_SCALE, o[0][1] * ACT_SCALE, o[0][2] * ACT_SCALE, o[0][3] * ACT_SCALE); w.y = pk4_fp8(o[1][0] * ACT_SCALE, o[1][1] * ACT_SCALE, o[1][2] * ACT_SCALE, o[1][3] * ACT_SCALE);
                *(u32x2*)((unsigned char*)act + (((size_t)(row >> 8) * (DFF / 128) + (ch0 >> 7)) * 256 + (row & 255)) * 128 + (ch0 & 127)) = w;
                } else {
                u32x4 w; w.x = cvt_pk_bf16(o[0][0], o[0][1]); w.y = cvt_pk_bf16(o[0][2], o[0][3]); w.z = cvt_pk_bf16(o[1][0], o[1][1]); w.w = cvt_pk_bf16(o[1][2], o[1][3]);
                *(u32x4*)(act + (((size_t)(row >> 8) * (DFF / 64) + (ch0 >> 6)) * 256 + (row & 255)) * 64 + (ch0 & 63)) = w;
                }
                if (ai == 0 && m == 0 && wr == 0 && fr < 2) {
                    float* sp = side + ((size_t)u.pm * 6 + fr) * DFF + ch0; *(f32x4*)sp = g[0]; *(f32x4*)(sp + 4) = g[1];
                    float* sv = side + ((size_t)u.pm * 6 + 4 + fr) * DFF + ch0; *(f32x4*)sv = vv[0]; *(f32x4*)(sv + 4) = vv[1]; }
                if (ai == 1 && m == 3 && wr == 1 && fr >= 14) {
                    float* sp = side + ((size_t)u.pm * 6 + 2 + (fr - 14)) * DFF + ch0; *(f32x4*)sp = g[0]; *(f32x4*)(sp + 4) = g[1]; }
                gprev[0] = g[0]; gprev[1] = g[1];
            }
        }
    }
};
constexpr size_t MiB = 1u << 20;
constexpr size_t WS_CTL = 0, CTL_ZERO_BYTES = 3 * MiB + 65536;
constexpr int CW_BAR = 4096;
constexpr size_t WS_SSQX = 1 * MiB;
constexpr size_t WS_SSQCQ = WS_SSQX + 4 * 131072;
constexpr size_t WS_SSQCKV = WS_SSQCQ + 2 * 131072;
constexpr size_t WS_SSQY = WS_SSQCKV + 2 * 131072;
constexpr size_t WS_DBG = 3 * MiB;
constexpr size_t WS_SSQX0 = 4 * MiB;
constexpr size_t WS_ROPE = WS_SSQX0 + 131072;
constexpr size_t WS_FLOG = 5 * MiB;
constexpr size_t WS_CUM = WS_FLOG + 512 * 1024;
constexpr size_t WS_KM = 6 * MiB;
constexpr size_t WS_SGUW = WS_KM + 512 * 1024;
constexpr size_t WS_SIDE = 8 * MiB;
constexpr size_t WS_W = 32 * MiB;
constexpr size_t WB_IN = 0, WB_UQ = WB_IN + (size_t)NINP * DM * 2, WB_UKV = WB_UQ + (size_t)1536 * 768 * 2, WB_O = WB_UKV + (size_t)2048 * 256 * 2,
                 WB_GV = WB_O + (size_t)DM * DM * 2, WB_D = WB_GV + (size_t)NGV * DM * 2, WB_LAYER = WB_D + (size_t)DM * DFF * 2;
constexpr size_t WS_XB = 768 * MiB;
constexpr size_t WS_Y = 896 * MiB;
constexpr size_t WS_PROJ = 1024 * MiB;
constexpr size_t WS_MLAQ = 1320 * MiB;
constexpr size_t WS_MLAKV = 1368 * MiB;
constexpr size_t WS_ACT = 1024 * MiB;
constexpr size_t WS_PART = 1432 * MiB;
constexpr size_t WS_END = 1452 * MiB;
static_assert(WS_W + 2 * WB_LAYER <= WS_XB && WS_PROJ + (size_t)M_TOK * NINP * 2 <= WS_MLAQ && WS_ACT + (size_t)M_TOK * DFF * 2 <= WS_PART && WS_PART + (size_t)4 * M_TOK * 72 * 4 <= WS_END && WS_SIDE + (size_t)64 * 6 * DFF * 4 <= WS_W, "ws map");
static_assert(WS_SSQY + 2 * 16384 * 4 * 8 <= WS_DBG && WS_DBG + 65536 <= CTL_ZERO_BYTES && WS_ROPE + 2048 * 64 * 4 <= WS_FLOG, "zero region");

constexpr int RING_BYTES = 131072;
constexpr int XCH_OFF = 133120;
constexpr int MISC_OFF = 140 * 1024;
constexpr int LDS_BYTES = 147456;

#define XB_TMO      128
#define XB_XCNT(j)  (256  + 64 * (j))
#define XB_XSUB(j)  (1280 + 64 * (j))
#define XB_XGEN(j)  (2304 + 64 * (j))
#define XB_TOP      3328
#define XB_TOPGEN   3392
#define XCD_BAR_WORDS 3456
#define XB_SPIN_CAP (1u << 18)
__device__ __forceinline__ unsigned xb_ld(unsigned* p)              { return __hip_atomic_load(p, __ATOMIC_RELAXED, __HIP_MEMORY_SCOPE_AGENT); }
__device__ __forceinline__ unsigned xb_add(unsigned* p, unsigned v) { return __hip_atomic_fetch_add(p, v, __ATOMIC_RELAXED, __HIP_MEMORY_SCOPE_AGENT); }
__device__ __forceinline__ unsigned xb_xcc_id() { return (unsigned)__builtin_amdgcn_s_getreg((3 << 11) | 20) & 0xFu; }
#define XB_SPIN(cond, bar) do { unsigned _sp = 0; while (cond) { __builtin_amdgcn_s_sleep(1); \
    if ((++_sp & 255u) == 0u) { if (xb_ld(&(bar)[XB_TMO])) break; if (_sp > XB_SPIN_CAP) { atomicAdd(&(bar)[XB_TMO], 1u); break; } } } } while (0)
struct XcdBarrier { unsigned* bar; unsigned x; volatile LAS unsigned* st; };
__device__ __forceinline__ XcdBarrier xcd_barrier_post(unsigned* bar, volatile LAS unsigned* st) {
    XcdBarrier b; b.bar = bar; b.x = xb_xcc_id(); b.st = st;
    if (threadIdx.x == 0) (void)xb_add(&bar[XB_XCNT(b.x)], 1u);
    return b;
}
__device__ __forceinline__ void xcd_barrier_complete(unsigned* bar, unsigned x, unsigned& nloc, unsigned& nx) {
    const unsigned G = gridDim.x * gridDim.y * gridDim.z;
    unsigned sum, cnt, mine, sp = 0u;
    for (;;) {
        sum = 0u; cnt = 0u; mine = 0u;
#pragma unroll
        for (unsigned j = 0; j < 16; ++j) { const unsigned c = xb_ld(&bar[XB_XCNT(j)]); sum += c; cnt += (c > 0u) ? 1u : 0u; mine = (j == x) ? c : mine; }
        if (sum == G) break;
        __builtin_amdgcn_s_sleep(1);
        if ((++sp & 255u) == 0u) { if (xb_ld(&bar[XB_TMO])) break; if (sp > XB_SPIN_CAP) { atomicAdd(&bar[XB_TMO], 1u); break; } }
    }
    nloc = mine > 0u ? mine : 1u; nx = cnt > 0u ? cnt : 1u;
}
__device__ __forceinline__ void xcd_barrier(const XcdBarrier& b) {
    asm volatile("s_waitcnt vmcnt(0)" ::: "memory");
    __syncthreads();
    if (threadIdx.x == 0) {
        unsigned* bar = b.bar; asm volatile("" : "+s"(bar));
        __builtin_amdgcn_s_waitcnt(0);
        unsigned nloc = b.st[0], nx = b.st[1];
        if (nloc == 0u) { xcd_barrier_complete(bar, b.x, nloc, nx); b.st[0] = nloc; b.st[1] = nx; }
        const unsigned old = xb_add(&bar[XB_XSUB(b.x)], 1u);
        const unsigned gen = old / nloc;
        if (old + 1u == (gen + 1u) * nloc) {
            __builtin_amdgcn_fence(__ATOMIC_RELEASE, "agent");
            asm volatile("s_waitcnt vmcnt(0)" ::: "memory");
            const unsigned og = xb_add(&bar[XB_TOP], 1u);
            const unsigned tg = og / nx;
            if (og + 1u == (tg + 1u) * nx) xb_add(&bar[XB_TOPGEN], 1u);
            else XB_SPIN(xb_ld(&bar[XB_TOPGEN]) == tg, bar);
            __builtin_amdgcn_fence(__ATOMIC_ACQUIRE, "agent");
            xb_add(&bar[XB_XGEN(b.x)], 1u);
            asm volatile("s_waitcnt vmcnt(0)" ::: "memory");
        } else {
            XB_SPIN(xb_ld(&bar[XB_XGEN(b.x)]) == gen, bar);
            __builtin_amdgcn_fence(__ATOMIC_ACQUIRE, "agent");
            asm volatile("s_waitcnt vmcnt(0)" ::: "memory");
        }
    }
    __syncthreads();
}

struct Args {
    const float* in[21]; float* out; unsigned char* ws; int ph_lo, ph_hi;
};
static_assert(sizeof(Args) == 23 * 8 + 8, "Args has no padding");
enum { I_X = 0, I_NMG, I_WIN, I_LNG, I_LNB, I_SGUW, I_SGUB, I_QNG, I_KVNG, I_WUQ, I_WUKV, I_BF, I_GNG, I_WO, I_NFG, I_WG, I_WV, I_CW, I_CB, I_WD, I_FNG };

__host__ __device__ __forceinline__ int ropeperm(int i) { return (i & 4) ? 32 + 4 * (i >> 3) + (i & 3) : 4 * (i >> 3) + (i & 3); }
struct TrDesc { const float* src; const float* gain; bf16* dst; int ldsrc, scol, mode, nv, k0, K, drow0, f8; float qs; };
constexpr int TR_IN = 64 * 148, TR_UQ = 12 * 24, TR_UKV = 4 * 32, TR_O = 64 * 64, TR_GV = 64 * 344, TR_D = 172 * 64, TR_LAYER = TR_IN + TR_UQ + TR_UKV + TR_O + TR_GV + TR_D;
__device__ __forceinline__ TrDesc tr_desc(const Args& a, int flat) {
    const int l = flat / TR_LAYER; int it = flat - l * TR_LAYER;
    unsigned char* wb = a.ws + WS_W + (size_t)l * WB_LAYER;
    TrDesc d; d.mode = 0; d.nv = 64; d.f8 = 0; d.qs = 1.0f;
    if (it < TR_IN) {
        const int kb = it / 148, j0 = (it % 148) * 64;
        d.src = a.in[I_WIN] + (size_t)l * DM * 9288; d.gain = a.in[I_NMG] + (size_t)l * DM; d.dst = (bf16*)(wb + WB_IN); d.ldsrc = 9288; d.k0 = kb * 64; d.K = DM; d.drow0 = j0;
        if (j0 < 6144) d.scol = j0; else if (j0 < 9216) d.scol = j0 + 64; else if (j0 == 9216) { d.scol = 6144; d.mode = 1; } else if (j0 == 9280) { d.scol = 9280; d.nv = 8; } else { d.scol = 0; d.nv = 0; }
        return d; }
    it -= TR_IN;
    if (it < TR_UQ) {
        const int kb = it / 24, j0 = (it % 24) * 64;
        d.src = a.in[I_WUQ] + (size_t)l * 768 * 1536; d.gain = a.in[I_QNG] + (size_t)l * 768; d.dst = (bf16*)(wb + WB_UQ); d.ldsrc = 1536; d.k0 = kb * 64; d.K = 768; d.drow0 = j0;
        if (j0 < 1024) d.scol = (j0 >> 7) * 192 + (j0 & 127); else { d.scol = ((j0 - 1024) >> 6) * 192 + 128; d.mode = 1; }
        return d; }
    it -= TR_UQ;
    if (it < TR_UKV) {
        const int kb = it / 32, j0 = (it % 32) * 64, jj = j0 & 1023;
        d.src = a.in[I_WUKV] + (size_t)l * 256 * 2048; d.gain = a.in[I_KVNG] + (size_t)l * 256; d.dst = (bf16*)(wb + WB_UKV); d.ldsrc = 2048; d.k0 = kb * 64; d.K = 256; d.drow0 = j0;
        d.scol = (jj >> 7) * 256 + (jj & 127) + ((j0 >= 1024) ? 128 : 0);
        return d; }
    it -= TR_UKV;
    if (it < TR_O) {
        const int kb = it / 64, j0 = (it % 64) * 64;
        d.src = a.in[I_WO] + (size_t)l * DM * DM; d.gain = a.in[I_GNG] + (size_t)l * DM; d.dst = (bf16*)(wb + WB_O); d.ldsrc = DM; d.k0 = kb * 64; d.K = DM; d.drow0 = j0; d.scol = j0;
        return d; }
    it -= TR_O;
    if (it < TR_GV) {
        const int kb = it / 344, j0 = (it % 344) * 64, t = j0 >> 8, w = j0 & 255;
        d.src = ((w < 128) ? a.in[I_WG] : a.in[I_WV]) + (size_t)l * DM * DFF; d.gain = a.in[I_NFG] + (size_t)l * DM; d.dst = (bf16*)(wb + WB_GV); d.ldsrc = DFF; d.k0 = kb * 64; d.K = DM; d.drow0 = j0;
        d.scol = t * 128 + (w & 127); d.f8 = (FP8_FFN1 >> l) & 1; d.qs = d.f8 ? WG_SCALE : 1.0f;
        return d; }
    it -= TR_GV;
    {
        const int kb = it / 64, j0 = (it % 64) * 64;
        d.src = a.in[I_WD] + (size_t)l * DFF * DM; d.gain = nullptr; d.dst = (bf16*)(wb + WB_D); d.ldsrc = DM; d.k0 = kb * 64; d.K = DFF; d.drow0 = j0; d.scol = j0; d.f8 = (FP8_LAYERS >> l) & 1; d.qs = d.f8 ? WD_SCALE : 1.0f;
        return d; }
}
__device__ __forceinline__ void tr_load(const TrDesc& d, int lane, f32x4 (&v)[16], float (&gn)[16]) {
    asm volatile("" : "+v"(lane));
    const int g4 = lane & 15, kr = lane >> 4, j0 = 4 * g4;
    const int col = d.scol + (d.mode ? ropeperm(j0) : j0);
    const bool valid = j0 < d.nv;
#pragma unroll
    for (int it = 0; it < 16; ++it) { const int kk = 4 * it + kr;
        v[it] = valid ? *(const f32x4*)(d.src + (size_t)(d.k0 + kk) * d.ldsrc + col) : (f32x4){0.f, 0.f, 0.f, 0.f};
        gn[it] = (d.gain ? d.gain[d.k0 + kk] : 1.0f) * d.qs; }
}
__device__ __forceinline__ void tr_store(const TrDesc& d, int lane, const f32x4 (&v)[16], const float (&gn)[16], LAS float* scr) {
    asm volatile("" : "+v"(lane));
    const int g4 = lane & 15, kr = lane >> 4, j0 = 4 * g4;
#pragma unroll
    for (int it = 0; it < 16; ++it) { const int kk = 4 * it + kr; const f32x4 w = v[it] * gn[it];
        LAS float* p = scr + kk * 65 + j0; p[0] = w[0]; p[1] = w[1]; p[2] = w[2]; p[3] = w[3]; }
    asm volatile("s_waitcnt lgkmcnt(0)" ::: "memory");
    const int c = lane & 7;
    if (d.f8) {
#pragma unroll
        for (int j = 0; j < 8; ++j) {
            const int n = (lane >> 3) + 8 * j; const LAS float* s = scr + (8 * c) * 65 + n;
            u32x2 o; o.x = pk4_fp8(s[0], s[65], s[2 * 65], s[3 * 65]); o.y = pk4_fp8(s[4 * 65], s[5 * 65], s[6 * 65], s[7 * 65]);
            *(u32x2*)((unsigned char*)d.dst + (size_t)(d.drow0 + n) * d.K + d.k0 + 8 * c) = o;
        }
    } else {
#pragma unroll
    for (int j = 0; j < 8; ++j) {
        const int n = (lane >> 3) + 8 * j; const LAS float* s = scr + (8 * c) * 65 + n;
        u32x4 o; o.x = cvt_pk_bf16(s[0], s[65]); o.y = cvt_pk_bf16(s[2 * 65], s[3 * 65]); o.z = cvt_pk_bf16(s[4 * 65], s[5 * 65]); o.w = cvt_pk_bf16(s[6 * 65], s[7 * 65]);
        *(u32x4*)(d.dst + (size_t)(d.drow0 + n) * d.K + d.k0 + 8 * c) = o;
    }
    }
    asm volatile("s_waitcnt lgkmcnt(0)" ::: "memory");
}
__device__ __forceinline__ void prologue_weights(const Args& a, int lo, int hi, LAS float* scr, int gw, int NGW, int lane) {
    int cur = lo + gw;
    if (cur >= hi) return;
    f32x4 v[16], vn[16]; float gn[16], gnn[16];
    TrDesc d = tr_desc(a, cur); tr_load(d, lane, v, gn);
    for (;;) {
        const int nxt = cur + NGW; const bool more = nxt < hi;
        TrDesc dn = d;
        if (more) { dn = tr_desc(a, nxt); tr_load(dn, lane, vn, gnn); }
        tr_store(d, lane, v, gn, scr);
        if (!more) break;
#pragma unroll
        for (int i = 0; i < 16; ++i) { v[i] = vn[i]; gn[i] = gnn[i]; }
        d = dn; cur = nxt;
    }
}
__device__ __forceinline__ void prologue_misc(const Args& a, int gw, int NGW, int lane, int gtid, int NT) {
    { const float* X = a.in[I_X]; bf16* XB = (bf16*)(a.ws + WS_XB); u64* S0 = (u64*)(a.ws + WS_SSQX0);
      for (int r = gw; r < M_TOK; r += NGW) { const f32x4* xr = (const f32x4*)(X + (size_t)r * DM) + lane; u32x2* o = (u32x2*)(XB + (size_t)r * DM) + lane; float s = 0.f;
          f32x4 vv[16];
#pragma unroll
          for (int j = 0; j < 16; ++j) vv[j] = xr[64 * j];
#pragma unroll
          for (int j = 0; j < 16; ++j) { const f32x4 v = vv[j]; s += (v[0] * v[0] + v[1] * v[1]) + (v[2] * v[2] + v[3] * v[3]); u32x2 w; w.x = cvt_pk_bf16(v[0], v[1]); w.y = cvt_pk_bf16(v[2], v[3]); o[64 * j] = w; }
          s = wave_sum(s); if (lane == 0) S0[r] = (u64)__float2ull_rz(s * 4294967296.0f); } }
    { float* R = (float*)(a.ws + WS_ROPE);
      for (int i = gtid; i < SEQ * 32; i += NT) { const int pos = i >> 5, j = i & 31; const double ang = (double)pos * pow(10000.0, -(double)j / 32.0); R[pos * 64 + j] = (float)cos(ang); R[pos * 64 + 32 + j] = (float)sin(ang); } }
    { const float* W = a.in[I_SGUW]; bf16* D = (bf16*)(a.ws + WS_SGUW);
      for (int i = gtid; i < 2 * 8 * 128 * 128; i += NT) { const int s = i & 127, t = (i >> 7) & 127; D[i] = (s <= t) ? f2bf(W[i]) : (bf16)0; } }
}
__device__ __forceinline__ s16x4 vtr(const LAS unsigned char* p) { return __builtin_bit_cast(s16x4, __builtin_amdgcn_ds_read_tr16_b64_v4i16((LAS s16x4*)p)); }
__device__ __forceinline__ bf16x8 cat4(s16x4 lo, s16x4 hi) { return (bf16x8){lo[0], lo[1], lo[2], lo[3], hi[0], hi[1], hi[2], hi[3]}; }
__device__ __forceinline__ float xmax32(float v) { const auto rr = __builtin_amdgcn_permlane32_swap(__float_as_uint(v), __float_as_uint(v), false, false); return fmaxf(__uint_as_float(rr[0]), __uint_as_float(rr[1])); }
__device__ __forceinline__ float xsum32(float v) { const auto rr = __builtin_amdgcn_permlane32_swap(__float_as_uint(v), __float_as_uint(v), false, false); return __uint_as_float(rr[0]) + __uint_as_float(rr[1]); }
__device__ __forceinline__ int crow(int r, int hi) { return (r & 3) + 8 * (r >> 2) + 4 * hi; }

__device__ __forceinline__ void job_kmean(const bf16* proj, float* km, int item, LAS unsigned char* lds) {
    int tid = threadIdx.x; asm volatile("" : "+v"(tid));
    const int b = item >> 6, h = (item >> 3) & 7, n = item & 7;
    const int ch = tid & 15, rs = tid >> 4;
    const bf16* kp = proj + ((size_t)(b * SEQ + n * 256 + rs)) * NINP + 1024 + h * 128 + ch * 8;
    float acc[8];
#pragma unroll
    for (int e = 0; e < 8; ++e) acc[e] = 0.f;
#pragma unroll
    for (int it = 0; it < 8; ++it) { const u32x4 v = *(const u32x4*)(kp + (size_t)(32 * it) * NINP);
#pragma unroll
        for (int e = 0; e < 4; ++e) { acc[2 * e] += __uint_as_float(v[e] << 16); acc[2 * e + 1] += __uint_as_float(v[e] & 0xffff0000u); } }
    LAS float* sc = (LAS float*)lds;
#pragma unroll
    for (int e = 0; e < 8; ++e) sc[rs * 128 + ch * 8 + e] = acc[e];
    __syncthreads();
    if (tid < 128) { float s = 0.f;
#pragma unroll 8
        for (int r = 0; r < 32; ++r) s += sc[r * 128 + tid];
        km[(size_t)item * 128 + tid] = s * (1.0f / 256.0f); }
    __syncthreads();
}
__device__ __forceinline__ void job_cum(const float* part, const u64* ssq_in, const float* bfp, float* cum, int item, LAS unsigned char* lds) {
    int tid = threadIdx.x; asm volatile("" : "+v"(tid));
    const int lane = tid & 63, wid = tid >> 6;
    const int b = item >> 3, h = item & 7; const float bias = bfp[h];
    const size_t r0 = (size_t)b * SEQ + tid * 4;
    const float* fp = part + r0 * 72 + 64 + h;
    float v[4]; float run = 0.f;
#pragma unroll
    for (int i = 0; i < 4; ++i) {
        const float raw = (fp[(size_t)i * 72] + fp[(size_t)i * 72 + (size_t)M_TOK * 72]) + (fp[(size_t)i * 72 + (size_t)2 * M_TOK * 72] + fp[(size_t)i * 72 + (size_t)3 * M_TOK * 72]);
        const float z = raw * __builtin_amdgcn_rsqf(ssq_get(ssq_in + r0 + i) * (1.0f / DM) + EPS) + bias;
        const float lf = fminf(z, 0.f) - log1pf(expf(-fabsf(z))); run += lf; v[i] = run; }
    float incl = run;
#pragma unroll
    for (int o = 1; o < 64; o <<= 1) { const float t = __shfl_up(incl, o); if (lane >= o) incl += t; }
    LAS float* wt = (LAS float*)lds;
    if (lane == 63) wt[wid] = incl;
    __syncthreads();
    float base = 0.f;
#pragma unroll
    for (int w = 0; w < 8; ++w) base += (w < wid) ? wt[w] : 0.f;
    const float excl = base + incl - run;
    *(f32x4*)(cum + (size_t)item * SEQ + tid * 4) = (f32x4){v[0] + excl, v[1] + excl, v[2] + excl, v[3] + excl};
    __syncthreads();
}
__device__ __forceinline__ void job_krope(const float* part, const u64* ssq_in, const float* rope, bf16* proj, int gtid, int NT) {
    for (int i = gtid; i < M_TOK * 8; i += NT) { const int row = i >> 3, a = i & 7;
        const float* p = part + (size_t)row * 72 + 8 * a;
        f32x4 x1 = *(const f32x4*)p, x2 = *(const f32x4*)(p + 4);
#pragma unroll
        for (int q = 1; q < 4; ++q) { x1 = x1 + *(const f32x4*)(p + (size_t)q * M_TOK * 72); x2 = x2 + *(const f32x4*)(p + (size_t)q * M_TOK * 72 + 4); }
        const float rs = __builtin_amdgcn_rsqf(ssq_get(ssq_in + row) * (1.0f / DM) + EPS);
        x1 = x1 * rs; x2 = x2 * rs;
        const float* rp = rope + (size_t)(row & (SEQ - 1)) * 64 + 4 * a;
        const f32x4 cs = *(const f32x4*)rp, sn = *(const f32x4*)(rp + 32);
        const f32x4 o1 = x1 * cs - x2 * sn, o2 = x2 * cs + x1 * sn;
        u32x4 w; w.x = cvt_pk_bf16(o1[0], o1[1]); w.y = cvt_pk_bf16(o1[2], o1[3]); w.z = cvt_pk_bf16(o2[0], o2[1]); w.w = cvt_pk_bf16(o2[2], o2[3]);
        *(u32x4*)(proj + (size_t)row * NINP + 9216 + 8 * a) = w; }
}
constexpr int VP = 320;
constexpr int UP = 272;
template <int CTRL, int ROWMASK = 0xF> __device__ __forceinline__ float dppmov(float v) { return __builtin_bit_cast(float, __builtin_amdgcn_update_dpp(0, __builtin_bit_cast(int, v), CTRL, ROWMASK, 0xF, false)); }
__device__ __forceinline__ float row16_allsum(float s) { s += dppmov<0x128>(s); s += dppmov<0x124>(s); s += dppmov<0x122>(s); s += dppmov<0x121>(s); return s; }
__device__ __forceinline__ float half32_sum_hi16(float s) { s = row16_allsum(s); return s + dppmov<0x142, 0xA>(s); }
struct SguRegs { u32x4 v[4], u[4]; };
__device__ __forceinline__ void sgu_load(SguRegs& R, const bf16* proj, int item, int tid) {
    const int b = item >> 7, c = (item >> 3) & 15, g = item & 7, ch = tid & 15, rs = tid >> 4;
    const bf16* p = proj + ((size_t)b * SEQ + c * 128 + rs) * NINP + g * 128 + ch * 8;
#pragma unroll
    for (int q = 0; q < 4; ++q) { R.v[q] = *(const u32x4*)(p + (size_t)(32 * q) * NINP + 4096); R.u[q] = *(const u32x4*)(p + (size_t)(32 * q) * NINP + 3072); }
}
#define LDS_BARRIER() do { asm volatile("s_waitcnt lgkmcnt(0)" ::: "memory"); __builtin_amdgcn_s_barrier(); asm volatile("" ::: "memory"); } while (0)
__device__ __forceinline__ void job_sgu_stream(const Args& a, int l, int first, int stride, int nitems, LAS unsigned char* lds, bool dummy = false) {
    int tid = threadIdx.x; asm volatile("" : "+v"(tid));
    const int wid = __builtin_amdgcn_readfirstlane(tid >> 6), lane = tid & 63, r32 = lane & 31, hi = lane >> 5;
    const bf16* proj = (const bf16*)(a.ws + WS_PROJ);
    bf16* Y = (bf16*)(a.ws + (dummy ? WS_END : WS_Y)); u64* ssq = dummy ? (u64*)(a.ws + WS_END + 128 * MiB) : (u64*)(a.ws + WS_SSQY) + (size_t)l * M_TOK * 4;
    const int ch = tid & 15, rs = tid >> 4, rg = wid & 3, dh = wid >> 2, t = 32 * rg + r32;
    LAS unsigned char* VT = lds;
    if (first >= nitems) return;
    SguRegs R; sgu_load(R, proj, first, tid);
    int par = 0;
    for (int item = first; item < nitems; item += stride, par ^= 1) {
        const int b = item >> 7, c = (item >> 3) & 15, g = item & 7;
        const size_t R0 = (size_t)b * SEQ + c * 128;
        LAS unsigned char* UT = lds + 40960 + par * (128 * UP);
        const float* lng = a.in[I_LNG] + (size_t)(l * 8 + g) * 128; const float* lnb = a.in[I_LNB] + (size_t)(l * 8 + g) * 128;
        const bf16* wp = (const bf16*)(a.ws + WS_SGUW) + ((size_t)((l * 8 + g) * 128 + t)) * 128 + hi * 8;
        bf16x8 af[8];
#pragma unroll
        for (int ks = 0; ks < 8; ++ks) af[ks] = *(const bf16x8*)(wp + ks * 16);
        { const f32x4 g0 = *(const f32x4*)(lng + ch * 8), g1 = *(const f32x4*)(lng + ch * 8 + 4), b0 = *(const f32x4*)(lnb + ch * 8), b1 = *(const f32x4*)(lnb + ch * 8 + 4);
#pragma unroll
          for (int p = 0; p < 4; ++p) { const int row = rs + 32 * p; const u32x4 v = R.v[p];
              float x[8];
#pragma unroll
              for (int e = 0; e < 4; ++e) { x[2 * e] = __uint_as_float(v[e] << 16); x[2 * e + 1] = __uint_as_float(v[e] & 0xffff0000u); }
              float s = 0.f;
#pragma unroll
              for (int e = 0; e < 8; ++e) s += x[e];
              const float mean = row16_allsum(s) * (1.0f / 128.0f); float q = 0.f;
#pragma unroll
              for (int e = 0; e < 8; ++e) { x[e] -= mean; q += x[e] * x[e]; }
              const float rstd = __builtin_amdgcn_rsqf(row16_allsum(q) * (1.0f / 128.0f) + EPS);
              u32x4 w; w.x = cvt_pk_bf16(x[0] * rstd * g0[0] + b0[0], x[1] * rstd * g0[1] + b0[1]); w.y = cvt_pk_bf16(x[2] * rstd * g0[2] + b0[2], x[3] * rstd * g0[3] + b0[3]);
              w.z = cvt_pk_bf16(x[4] * rstd * g1[0] + b1[0], x[5] * rstd * g1[1] + b1[1]); w.w = cvt_pk_bf16(x[6] * rstd * g1[2] + b1[2], x[7] * rstd * g1[3] + b1[3]);
              *(LAS u32x4*)(VT + row * VP + ch * 16) = w;
              *(LAS u32x4*)(UT + row * UP + ch * 16) = R.u[p]; } }
        if (item + stride < nitems) sgu_load(R, proj, item + stride, tid);
        LDS_BARRIER();
        f32x16 o[2];
#pragma unroll
        for (int dd = 0; dd < 2; ++dd)
#pragma unroll
            for (int r = 0; r < 16; ++r) o[dd][r] = 0.f;
        const LAS unsigned char* vb = VT + (8 * (lane >> 5) + ((lane & 15) >> 2)) * VP + (16 * ((lane >> 4) & 1) + 4 * (lane & 3)) * 2;
#pragma unroll
        for (int ks = 0; ks < 8; ++ks) {
            if (ks < 2 * rg + 2) {
#pragma unroll
                for (int dd = 0; dd < 2; ++dd) { const int d0 = 2 * dh + dd;
                    const s16x4 lo = vtr(vb + (16 * ks) * VP + d0 * 64), hh = vtr(vb + (16 * ks + 4) * VP + d0 * 64);
                    o[dd] = __builtin_amdgcn_mfma_f32_32x32x16_bf16(af[ks], cat4(lo, hh), o[dd], 0, 0, 0); } }
        }
        const float* bs = a.in[I_SGUB] + (size_t)(l * 8 + g) * 128;
#pragma unroll
        for (int r = 0; r < 16; ++r) { const int tt = 32 * rg + crow(r, hi); const float bt = bs[tt]; float ss = 0.f;
#pragma unroll
            for (int dd = 0; dd < 2; ++dd) { const int col = (2 * dh + dd) * 32 + r32;
                LAS unsigned short* up = (LAS unsigned short*)(UT + tt * UP) + col;
                const float v = (o[dd][r] + bt) * bf2f(*up); ss += v * v;
                const float vn = dppmov<0xB1>(v);
                if ((r32 & 1) == 0) *(LAS unsigned*)up = cvt_pk_bf16(v, vn); }
            ss = half32_sum_hi16(ss);
            if (r32 == 16) ssq_add(ssq + (R0 + tt) * 4 + 1, ss); }
        LDS_BARRIER();
#pragma unroll
        for (int p = 0; p < 4; ++p) { const int row = rs + 32 * p;
            *(u32x4*)(Y + (R0 + row) * DM + 1024 + g * 128 + ch * 8) = *(const LAS u32x4*)(UT + row * UP + ch * 16); }
    }
    LDS_BARRIER();
}

namespace att {
constexpr int KBUF = 25600, VBUF = 64 * VP, OFF_K = 0, OFF_V = 2 * KBUF, OFF_KM = OFF_V + 2 * VBUF, OFF_C = OFF_KM + 32 * 272, OFF_W = OFF_C + 512, LDS_USED = OFF_W + 8 * 64 * 4;
static_assert(LDS_USED <= RING_BYTES, "attention LDS");
struct P { const bf16* Qn; int ldq; const bf16* Qr; int ldqr; const bf16* Kn; int ldk; const bf16* Kr; int ldkr; const bf16* V; int ldv; const float* km; const float* cum; bf16* Y; u64* ssq; int grp; };

template <int MODE, int EXPV = 0> __device__ __forceinline__ void attn_block(const P& p, int b, int h, int qb, LAS unsigned char* lds) {
    constexpr int DK = (MODE == 1) ? 192 : 128, ND = DK / 16, KP = DK * 2 + 16;
    constexpr float SCALE = (MODE == 1) ? 0.07216878364870322f : 0.08838834764831845f;
    constexpr float C2 = SCALE * L2E, THR = 6.0f, NEG = -__builtin_inff();
    int tid = threadIdx.x; asm volatile("" : "+v"(tid));
    const int wid = __builtin_amdgcn_readfirstlane(tid >> 6), lane = tid & 63, r32 = lane & 31, hi = lane >> 5;
    const int q0 = qb * 256 + wid * 32, trow = q0 + r32;
    const size_t rb = (size_t)b * SEQ;
    bf16x8 qr[ND];
    { const bf16* qp = p.Qn + (rb + trow) * p.ldq + h * 128 + hi * 8;
#pragma unroll
      for (int d0 = 0; d0 < 8; ++d0) qr[d0] = *(const bf16x8*)(qp + d0 * 16);
      if constexpr (MODE == 1) { const bf16* qp2 = p.Qr + (rb + trow) * p.ldqr + h * 64 + hi * 8;
#pragma unroll
          for (int d0 = 0; d0 < 4; ++d0) qr[8 + d0] = *(const bf16x8*)(qp2 + d0 * 16); } }
    const int srow = tid >> 4, sch = tid & 15, rrow = tid >> 3, rch = tid & 7;
    const bf16* kg = p.Kn + rb * p.ldk + h * 128 + sch * 8;
    const bf16* vg = p.V + rb * p.ldv + h * 128 + sch * 8;
    const bf16* krg = (MODE == 1) ? p.Kr + rb * p.ldkr + rch * 8 : nullptr;
    const float* cg = (MODE == 2) ? p.cum + ((size_t)(b * 8 + h)) * SEQ : nullptr;
    u32x4 sk0, sk1, sv0, sv1, skr; float scv = 0.f;
#define ATT_LOAD(j) do { const size_t k0_ = (size_t)(j) * 64; sk0 = *(const u32x4*)(kg + (k0_ + srow) * p.ldk); sk1 = *(const u32x4*)(kg + (k0_ + srow + 32) * p.ldk); \
        sv0 = *(const u32x4*)(vg + (k0_ + srow) * p.ldv); sv1 = *(const u32x4*)(vg + (k0_ + srow + 32) * p.ldv); \
        if constexpr (MODE == 1) skr = *(const u32x4*)(krg + (k0_ + rrow) * p.ldkr); \
        if constexpr (MODE == 2) { if (tid < 64) scv = cg[k0_ + tid]; } } while (0)
#define ATT_WRITE(bf) do { LAS unsigned char* kb_ = lds + OFF_K + (bf) * KBUF; LAS unsigned char* vb_ = lds + OFF_V + (bf) * VBUF; \
        *(LAS u32x4*)(kb_ + srow * KP + sch * 16) = sk0; *(LAS u32x4*)(kb_ + (srow + 32) * KP + sch * 16) = sk1; \
        *(LAS u32x4*)(vb_ + srow * VP + sch * 16) = sv0; *(LAS u32x4*)(vb_ + (srow + 32) * VP + sch * 16) = sv1; \
        if constexpr (MODE == 1) *(LAS u32x4*)(kb_ + rrow * KP + 256 + rch * 16) = skr; \
        if constexpr (MODE == 2) { if (tid < 64) ((LAS float*)(lds + OFF_C))[(bf) * 64 + tid] = scv; } } while (0)
    const int nt = (EXPV & 32) ? 1 : 4 * (qb + 1);
    ATT_LOAD(0);
    unsigned selmask = 0u; float slope2 = 0.f;
    if constexpr (MODE == 0) {
        slope2 = __builtin_amdgcn_exp2f(-(float)(h + 1)) * L2E;
        const f32x2 x = *(const f32x2*)(p.km + ((size_t)(b * 8 + h)) * 1024 + 2 * tid);
        const int n = tid >> 6, d = (2 * tid) & 127;
        const unsigned short h0 = f2bf(x[0]), h1 = f2bf(x[1]); const unsigned short l0 = f2bf(x[0] - bf2f(h0)), l1 = f2bf(x[1] - bf2f(h1));
        *(LAS unsigned*)(lds + OFF_KM + n * 272 + d * 2) = (unsigned)h0 | ((unsigned)h1 << 16);
        *(LAS unsigned*)(lds + OFF_KM + (8 + n) * 272 + d * 2) = (unsigned)l0 | ((unsigned)l1 << 16);
        for (int i = tid; i < 1088; i += 512) ((LAS unsigned*)(lds + OFF_KM + 16 * 272))[i] = 0u;
    }
    ATT_WRITE(0);
    if (nt > 1) ATT_LOAD(1);
    LDS_BARRIER();
    if constexpr (MODE == 0) {
        f32x16 g;
#pragma unroll
        for (int r = 0; r < 16; ++r) g[r] = 0.f;
        const LAS unsigned char* ka = lds + OFF_KM + r32 * 272 + hi * 16;
#pragma unroll
        for (int d0 = 0; d0 < 8; ++d0) g = __builtin_amdgcn_mfma_f32_32x32x16_bf16(*(const LAS bf16x8*)(ka + d0 * 32), qr[d0], g, 0, 0, 0);
        float gv[8];
#pragma unroll
        for (int r = 0; r < 4; ++r) { const float own = g[r] + g[4 + r], oth = __shfl_xor(own, 32); gv[r] = hi ? oth : own; gv[4 + r] = hi ? own : oth; }
#pragma unroll
        for (int n = 0; n < 8; ++n) if (n >= qb) gv[n] = NEG;
#pragma unroll
        for (int n = 0; n < 8; ++n) { int rank = 0;
#pragma unroll
            for (int m = 0; m < 8; ++m) if (m != n) rank += ((gv[m] > gv[n]) || (gv[m] == gv[n] && m < n)) ? 1 : 0;
            if (n < qb && rank < 3) selmask |= 1u << n; }
    }
    float crl = 0.f;
    if constexpr (MODE == 2) crl = cg[trow] * L2E;
    float m_reg = -128.f, l_reg = 0.f;
    float bc[16];
#pragma unroll
    for (int r = 0; r < 16; ++r) bc[r] = (MODE == 0) ? slope2 * (float)((r & 3) + 8 * (r >> 2)) : 0.f;
    f32x16 o[4];
#pragma unroll
    for (int d0 = 0; d0 < 4; ++d0)
#pragma unroll
        for (int r = 0; r < 16; ++r) o[d0][r] = 0.f;
    LAS float* al = (LAS float*)(lds + OFF_W) + wid * 64;
    for (int j = 0; j < nt; ++j) {
        const int bf = j & 1, kb = j * 64;
        if (j + 1 < nt) { ATT_WRITE(bf ^ 1); if (j + 2 < nt) ATT_LOAD(j + 2); }
        if (kb <= q0 + 31) {
#pragma unroll
          for (int hf = 0; hf < 2; ++hf) {
            const int kh = kb + 32 * hf;
            if (kh > q0 + 31) break;
            f32x16 p0;
#pragma unroll
            for (int r = 0; r < 16; ++r) p0[r] = 0.f;
            { const LAS unsigned char* ka = lds + OFF_K + bf * KBUF + (32 * hf + r32) * KP + hi * 16;
#pragma unroll
              for (int d0 = 0; d0 < ((EXPV & 8) ? 1 : ND); ++d0) {
                  const bf16x8 a0 = *(const LAS bf16x8*)(ka + d0 * 32);
                  p0 = __builtin_amdgcn_mfma_f32_32x32x16_bf16(a0, qr[d0], p0, 0, 0, 0);
                  if ((d0 & 3) == 3) __builtin_amdgcn_sched_barrier(0); } }
            const int dq = trow - kh - 4 * hi;
            if (!(EXPV & 2)) {
            if constexpr (MODE == 0) {
                const int blkn = kb >> 8; const bool sel = (blkn == qb) || ((selmask >> blkn) & 1u);
                const float bm = sel ? (-slope2 * (float)dq - m_reg) : NEG;
#pragma unroll
                for (int r = 0; r < 16; ++r) p0[r] = fmaf(p0[r], C2, bc[r] + bm);
            } else if constexpr (MODE == 1) {
                const float bm = -m_reg;
#pragma unroll
                for (int r = 0; r < 16; ++r) p0[r] = fmaf(p0[r], C2, bm);
            } else {
                const float bm = crl - m_reg;
                const LAS float* cb = (const LAS float*)(lds + OFF_C) + bf * 64 + 32 * hf + 4 * hi;
#pragma unroll
                for (int g4 = 0; g4 < 4; ++g4) { const f32x4 ca = *(const LAS f32x4*)(cb + 8 * g4);
#pragma unroll
                    for (int e = 0; e < 4; ++e) p0[4 * g4 + e] = fmaf(p0[4 * g4 + e], C2, fmaf(ca[e], -L2E, bm)); }
            }
            if (kh + 31 > q0) {
#pragma unroll
                for (int r = 0; r < 16; ++r) { const int c = (r & 3) + 8 * (r >> 2); if (c > dq) p0[r] = NEG; }
            }
            float pm = p0[0];
#pragma unroll
            for (int r = 1; r < 16; ++r) pm = fmaxf(pm, p0[r]);
            pm = xmax32(pm);
            if (__all(pm < -160.f)) continue;
            float alpha = 1.f;
            if (!__all(pm <= THR)) {
                const float d = fmaxf(pm, 0.f); alpha = __builtin_amdgcn_exp2f(-d); m_reg += d;
#pragma unroll
                for (int r = 0; r < 16; ++r) p0[r] -= d; }
            float ps = 0.f;
#pragma unroll
            for (int r = 0; r < 16; ++r) { p0[r] = __builtin_amdgcn_exp2f(p0[r]); ps += p0[r]; }
            ps = xsum32(ps);
            l_reg = l_reg * alpha + ps;
            if (__any(alpha < 1.f)) {
                if (hi == 0) al[r32] = alpha;
                asm volatile("s_waitcnt lgkmcnt(0)" ::: "memory");
#pragma unroll
                for (int g4 = 0; g4 < 4; ++g4) { const f32x4 av = *(const LAS f32x4*)(al + 8 * g4 + 4 * hi);
#pragma unroll
                    for (int d0 = 0; d0 < 4; ++d0)
#pragma unroll
                        for (int e = 0; e < 4; ++e) o[d0][4 * g4 + e] *= av[e]; }
                asm volatile("s_waitcnt lgkmcnt(0)" ::: "memory");
            }
            }
            bf16x8 pa[2];
#pragma unroll
            for (int ks = 0; ks < 2; ++ks) {
                u32x4 w; w.x = cvt_pk_bf16(p0[8 * ks], p0[8 * ks + 1]); w.y = cvt_pk_bf16(p0[8 * ks + 2], p0[8 * ks + 3]); w.z = cvt_pk_bf16(p0[8 * ks + 4], p0[8 * ks + 5]); w.w = cvt_pk_bf16(p0[8 * ks + 6], p0[8 * ks + 7]);
                pa[ks] = __builtin_bit_cast(bf16x8, w); }
            const LAS unsigned char* vb = lds + OFF_V + bf * VBUF + (32 * hf + 4 * (lane >> 5) + ((lane & 15) >> 2)) * VP + (16 * ((lane >> 4) & 1) + 4 * (lane & 3)) * 2;
#pragma unroll
            for (int d0 = 0; d0 < ((EXPV & 4) ? 1 : 4); ++d0) {
#pragma unroll
                for (int ks = 0; ks < 2; ++ks) {
                    const s16x4 lo = vtr(vb + (16 * ks) * VP + d0 * 64), hh = vtr(vb + (16 * ks + 8) * VP + d0 * 64);
                    o[d0] = __builtin_amdgcn_mfma_f32_32x32x16_bf16(pa[ks], cat4(lo, hh), o[d0], 0, 0, 0); }
                if (d0 & 1) __builtin_amdgcn_sched_barrier(0); }
          }
        }
        LDS_BARRIER();
    }
#undef ATT_LOAD
#undef ATT_WRITE
    LAS float* li = al + 32;
    if (hi == 0) li[r32] = l_reg;
    asm volatile("s_waitcnt lgkmcnt(0)" ::: "memory");
#pragma unroll
    for (int g4 = 0; g4 < 4; ++g4) { const f32x4 lv = *(const LAS f32x4*)(li + 8 * g4 + 4 * hi);
#pragma unroll
        for (int e = 0; e < 4; ++e) { const int r = 4 * g4 + e; const float inv = __builtin_amdgcn_rcpf(lv[e]);
            const size_t grow = rb + q0 + crow(r, hi); float ss = 0.f;
#pragma unroll
            for (int d0 = 0; d0 < 4; ++d0) { const float v = o[d0][r] * inv; ss += v * v; const float vn = __shfl_xor(v, 1);
                if ((r32 & 1) == 0) *(unsigned*)(p.Y + grow * DM + p.grp * 1024 + h * 128 + d0 * 32 + r32) = cvt_pk_bf16(v, vn); }
            ss += __shfl_xor(ss, 1); ss += __shfl_xor(ss, 2); ss += __shfl_xor(ss, 4); ss += __shfl_xor(ss, 8); ss += __shfl_xor(ss, 16);
            if (r32 == 0) ssq_add(p.ssq + grow * 4 + p.grp, ss); } }
    asm volatile("s_waitcnt lgkmcnt(0)" ::: "memory");
    __syncthreads();
}
}
__device__ __forceinline__ void job_ynorm(bf16* Y, const u64* ssqy, int gw, int NGW, int lane) {
    for (int r = gw; r < M_TOK; r += NGW) {
        float s4[4];
#pragma unroll
        for (int g = 0; g < 4; ++g) s4[g] = ssq_get(ssqy + (size_t)r * 4 + g);
        u32x4* yp = (u32x4*)(Y + (size_t)r * DM) + lane;
#pragma unroll
        for (int i = 0; i < 8; ++i) { const float rs = __builtin_amdgcn_rsqf(s4[i >> 1] * (1.0f / 1024.0f) + EPS);
            u32x4 v = yp[64 * i];
#pragma unroll
            for (int e = 0; e < 4; ++e) v[e] = cvt_pk_bf16(__uint_as_float(v[e] << 16) * rs, __uint_as_float(v[e] & 0xffff0000u) * rs);
            yp[64 * i] = v; }
    }
}
__device__ __forceinline__ void job_halo(const float* side, const float* cw, const float* cb, bf16* act, int gtid, int NT, bool f8) {
    for (int i = gtid; i < 64 * 2 * (DFF / 4); i += NT) {
        const int c4 = i % (DFF / 4), rr = (i / (DFF / 4)) & 1, pm = i / (2 * (DFF / 4));
        if ((pm & 7) == 0) continue;
        const int c = 4 * c4;
        const f32x4 gm2 = *(const f32x4*)(side + ((size_t)(pm - 1) * 6 + 2 + rr) * DFF + c);
        const f32x4 gm1 = rr ? *(const f32x4*)(side + ((size_t)pm * 6 + 0) * DFF + c) : *(const f32x4*)(side + ((size_t)(pm - 1) * 6 + 3) * DFF + c);
        const f32x4 g0 = *(const f32x4*)(side + ((size_t)pm * 6 + rr) * DFF + c), v = *(const f32x4*)(side + ((size_t)pm * 6 + 4 + rr) * DFF + c);
        const f32x4 w0 = *(const f32x4*)(cw + c), w1 = *(const f32x4*)(cw + DFF + c), w2 = *(const f32x4*)(cw + 2 * DFF + c), bb = *(const f32x4*)(cb + c);
        float o[4];
#pragma unroll
        for (int e = 0; e < 4; ++e) o[e] = silu_f(bb[e] + w0[e] * gm2[e] + w1[e] * gm1[e] + w2[e] * g0[e]) * v[e];
        if (f8) *(unsigned*)((unsigned char*)act + (((size_t)pm * (DFF / 128) + (c >> 7)) * 256 + rr) * 128 + (c & 127)) = pk4_fp8(o[0] * ACT_SCALE, o[1] * ACT_SCALE, o[2] * ACT_SCALE, o[3] * ACT_SCALE);
        else { u32x2 w; w.x = cvt_pk_bf16(o[0], o[1]); w.y = cvt_pk_bf16(o[2], o[3]);
            *(u32x2*)(act + (((size_t)pm * (DFF / 64) + (c >> 6)) * 256 + rr) * 64 + (c & 63)) = w; }
    }
}
__device__ __forceinline__ void job_final(float* out, const bf16* xb, const u64* ssq, const float* g, int gw, int NGW, int lane, float pscale) {
    for (int r = gw; r < M_TOK; r += NGW) {
        const float rs = __builtin_amdgcn_rsqf(ssq_get(ssq + r) * (1.0f / DM) + EPS) * pscale;
        f32x4* op = (f32x4*)(out + (size_t)r * DM) + lane; const f32x4* gp = (const f32x4*)g + lane; const u32x2* xp = (const u32x2*)(xb + (size_t)r * DM) + lane;
        u32x2 tt[16];
#pragma unroll
        for (int j = 0; j < 16; ++j) tt[j] = xp[64 * j];
#pragma unroll
        for (int j = 0; j < 16; ++j) { const u32x2 t = tt[j];
            const f32x4 v = (f32x4){__uint_as_float(t.x << 16), __uint_as_float(t.x & 0xffff0000u), __uint_as_float(t.y << 16), __uint_as_float(t.y & 0xffff0000u)};
            op[64 * j] = v * rs * gp[64 * j]; }
    }
}
#ifndef MK_PROBE_T0
#define MK_PROBE_T0 0
#endif
#ifndef TR_TAIL
#define TR_TAIL 3584
#endif
#ifndef FFN2_WGM
#define FFN2_WGM 2
#endif
constexpr int NPHASE = 18;
__global__ void __launch_bounds__(512, 2) hymba_fwd(Args a) {
    extern __shared__ __attribute__((aligned(16))) unsigned char lds_raw[];
    LAS unsigned char* lds = (LAS unsigned char*)lds_raw;
    volatile LAS unsigned* MISC = (volatile LAS unsigned*)(lds + MISC_OFF);
    const int tid = threadIdx.x;
    const int G = gridDim.x; const int bx = blockIdx.x; const int vcu = (G % 8 == 0) ? (bx % 8) * (G / 8) + bx / 8 : bx;
    const int NGW = G * 8, NT = G * 512;
#define LANEVARS() int tid_ = threadIdx.x; asm volatile("" : "+v"(tid_)); const int lane = tid_ & 63, wave = __builtin_amdgcn_readfirstlane(tid_ >> 6), gw = vcu * 8 + wave, gtid = vcu * 512 + tid_; (void)lane; (void)gw; (void)gtid
    unsigned char* ws = a.ws;
    for (int u = tid; u < 64; u += 512) MISC[u] = 0u;
    __syncthreads();
#if !MK_MULTI
    XcdBarrier bar = xcd_barrier_post((unsigned*)(ws + WS_CTL) + CW_BAR, MISC + 8);
#define GRID_BAR() xcd_barrier(bar)
#else
#define GRID_BAR() do { } while (0)
#endif
    const int lo = a.ph_lo, hi_ = a.ph_hi;
#define IN(k) (lo <= (k) && (k) < hi_)
#define SEAM(k) do { if (IN(k) && IN((k) + 1)) GRID_BAR(); } while (0)
    bf16* XB = (bf16*)(ws + WS_XB); bf16* Y = (bf16*)(ws + WS_Y); bf16* PROJ = (bf16*)(ws + WS_PROJ); bf16* MLAQ = (bf16*)(ws + WS_MLAQ); bf16* MLAKV = (bf16*)(ws + WS_MLAKV); bf16* ACT = (bf16*)(ws + WS_ACT);
    unsigned char* XB8 = ws + WS_MLAKV;
    u64* SSQX = (u64*)(ws + WS_SSQX); u64* SSQX0 = (u64*)(ws + WS_SSQX0); float* SIDE = (float*)(ws + WS_SIDE);
    const float* ROPE = (const float*)(ws + WS_ROPE); float* PART = (float*)(ws + WS_PART); float* CUM = (float*)(ws + WS_CUM); float* KM = (float*)(ws + WS_KM);

    if (IN(0)) {
        LANEVARS();
        LAS float* scr = (LAS float*)(lds + wave * 16640);
        prologue_misc(a, gw, NGW, lane, gtid, NT);
        prologue_weights(a, 0, 2 * TR_LAYER - TR_TAIL, scr, gw, NGW, lane);
        __syncthreads();
    }
    SEAM(0);
    for (int l = 0; l < 2; ++l) {
        const int pb = 1 + 8 * l;
        const unsigned char* wb = ws + WS_W + (size_t)l * WB_LAYER;
        const u64* ssq_in0 = (l == 0) ? SSQX0 : SSQX + 1 * M_TOK;
        u64* ssq_mid = SSQX + (size_t)(2 * l) * M_TOK;
        u64* ssq_end = SSQX + (size_t)(2 * l + 1) * M_TOK;
        u64* ssq_cq = (u64*)(ws + WS_SSQCQ) + (size_t)l * M_TOK; u64* ssq_ckv = (u64*)(ws + WS_SSQCKV) + (size_t)l * M_TOK;
        u64* ssq_y = (u64*)(ws + WS_SSQY) + (size_t)l * M_TOK * 4;
        if (IN(pb + 0)) {
            { pg8::Gemm g{XB, (const bf16*)(wb + WB_IN), M_TOK, 9216, DM, DM, DM, 0}; pg8::StaticOrder S; S.init(M_TOK, 9216, G, bx);
              EpiProj<0> E{PROJ, NINP, ssq_in0, 1.0f / DM, ssq_cq, ssq_ckv, ROPE, nullptr};
              pg8::gemm_phase<EpiProj<0>, pg8::StaticOrder>(lds, g, S, E); }
            for (int su = bx; su < 256; su += G) {
              const int kq = su & 3;
              pg8::Gemm g{XB + kq * 1024, (const bf16*)(wb + WB_IN) + kq * 1024, M_TOK, NINP, 1024, DM, DM, 0}; OneUnit S{su >> 2, 36};
              EpiPart E{PART + (size_t)kq * M_TOK * 72};
              pg8::gemm_phase<EpiPart, OneUnit>(lds, g, S, E); }
        }
        SEAM(pb + 0);
        if (IN(pb + 1)) {
            { pg8::Gemm g{PROJ + 5120, (const bf16*)(wb + WB_UQ), M_TOK, 1536, 768, NINP, 768, 0}; pg8::StaticOrder S; S.init(M_TOK, 1536, G, bx);
              EpiProj<1> E{MLAQ, 1536, ssq_cq, 1.0f / 768.0f, nullptr, nullptr, ROPE, nullptr};
              pg8::gemm_phase<EpiProj<1>, pg8::StaticOrder>(lds, g, S, E); }
            { pg8::Gemm g{PROJ + 5888, (const bf16*)(wb + WB_UKV), M_TOK, 2048, 256, NINP, 256, 0}; pg8::StaticOrder S; S.init(M_TOK, 2048, G, bx);
              EpiProj<2> E{MLAKV, 2048, ssq_ckv, 1.0f / 256.0f, nullptr, nullptr, ROPE, nullptr};
              pg8::gemm_phase<EpiProj<2>, pg8::StaticOrder>(lds, g, S, E); }
            for (int it = vcu; it < 512; it += G) job_kmean(PROJ, KM, it, lds);
            for (int it = vcu; it < 64; it += G) job_cum(PART, ssq_in0, a.in[I_BF] + l * 8, CUM, it, lds);
            { LANEVARS(); job_krope(PART, ssq_in0, ROPE, PROJ, gtid, NT); }
            job_sgu_stream(a, l, vcu, G, 1024, lds);
        }
        SEAM(pb + 1);
        if (IN(pb + 2)) {
            { att::P p{PROJ, NINP, nullptr, 0, PROJ + 1024, NINP, nullptr, 0, PROJ + 2048, NINP, KM, nullptr, Y, ssq_y, 0};
              for (int it = vcu; it < 256; it += G) { const int bh = it >> 2, pr = it & 3;
                  for (int ps = 0; ps < 2; ++ps) att::attn_block<0>(p, bh >> 3, bh & 7, ps ? pr : 7 - pr, lds); } }
            { att::P p{MLAQ, 1536, MLAQ + 1024, 1536, MLAKV, 2048, PROJ + 9216, NINP, MLAKV + 1024, 2048, nullptr, nullptr, Y, ssq_y, 2};
              for (int it = vcu; it < 256; it += G) { const int bh = it >> 2, pr = it & 3;
                  for (int ps = 0; ps < 2; ++ps) att::attn_block<1>(p, bh >> 3, bh & 7, ps ? pr : 7 - pr, lds); } }
            { att::P p{PROJ + 6144, NINP, nullptr, 0, PROJ + 7168, NINP, nullptr, 0, PROJ + 8192, NINP, nullptr, CUM, Y, ssq_y, 3};
              for (int it = vcu; it < 256; it += G) { const int bh = it >> 2, pr = it & 3;
                  for (int ps = 0; ps < 2; ++ps) att::attn_block<2>(p, bh >> 3, bh & 7, ps ? pr : 7 - pr, lds); } }
        }
        SEAM(pb + 2);
        if (IN(pb + 4)) {
            pg8::Gemm g{Y, (const bf16*)(wb + WB_O), M_TOK, DM, DM, DM, DM, 0}; pg8::StaticOrder S; S.init(M_TOK, DM, G, bx);
            unsigned char* xb8 = ((FP8_FFN1 >> l) & 1) ? XB8 : nullptr;
            if (l == 0) { EpiResid<true, true> E{a.in[I_X], XB, ssq_mid, ssq_y, (LAS float*)(lds + XCH_OFF), xb8}; pg8::gemm_phase<EpiResid<true, true>, pg8::StaticOrder>(lds, g, S, E); }
            else { EpiResid<false, true> E{nullptr, XB, ssq_mid, ssq_y, (LAS float*)(lds + XCH_OFF), xb8}; pg8::gemm_phase<EpiResid<false, true>, pg8::StaticOrder>(lds, g, S, E); }
        }
        SEAM(pb + 4);
        if (IN(pb + 5)) {
            pg8::Gemm g{XB, (const bf16*)(wb + WB_GV), M_TOK, NGV, DM, DM, DM, 0}; pg8::StaticOrder S; S.init(M_TOK, NGV, G, bx);
            if ((FP8_FFN1 >> l) & 1) { if constexpr (FP8_FFN1 != 0) {
                pg8::Gemm g8{(const bf16*)XB8, (const bf16*)(wb + WB_GV), M_TOK, NGV, DM / 2, DM / 2, DM / 2, 0};
                EpiFfn1<true, true> E{ACT, ssq_mid, a.in[I_CW] + (size_t)l * 3 * DFF, a.in[I_CB] + (size_t)l * DFF, SIDE, (LAS float*)(lds + XCH_OFF)};
                pg8::gemm_phase<EpiFfn1<true, true>, pg8::StaticOrder>(lds, g8, S, E); } }
            else if ((FP8_LAYERS >> l) & 1) { EpiFfn1<true> E{ACT, ssq_mid, a.in[I_CW] + (size_t)l * 3 * DFF, a.in[I_CB] + (size_t)l * DFF, SIDE, (LAS float*)(lds + XCH_OFF)};
                pg8::gemm_phase<EpiFfn1<true>, pg8::StaticOrder>(lds, g, S, E); }
            else { EpiFfn1<false> E{ACT, ssq_mid, a.in[I_CW] + (size_t)l * 3 * DFF, a.in[I_CB] + (size_t)l * DFF, SIDE, (LAS float*)(lds + XCH_OFF)};
                pg8::gemm_phase<EpiFfn1<false>, pg8::StaticOrder>(lds, g, S, E); }
            if (l == 0) {
                const int nun = (M_TOK / 256) * (NGV / 256), first = nun % G, nw = (first == 0) ? G : G - first;
                if (first == 0 || bx >= first) { LANEVARS(); (void)gw;
                    prologue_weights(a, 2 * TR_LAYER - TR_TAIL, 2 * TR_LAYER, (LAS float*)(lds + wave * 16640), ((first == 0) ? bx : bx - first) * 8 + wave, nw * 8, lane); }
            }
        }
        SEAM(pb + 5);
        if (IN(pb + 6)) { LANEVARS(); job_halo(SIDE, a.in[I_CW] + (size_t)l * 3 * DFF, a.in[I_CB] + (size_t)l * DFF, ACT, gtid, NT, (FP8_LAYERS >> l) & 1); }
        SEAM(pb + 6);
        if (IN(pb + 7)) {
            if ((FP8_LAYERS >> l) & 1) {
            pg8::Gemm g{ACT, (const bf16*)(wb + WB_D), M_TOK, DM, DFF / 2, 64, DFF / 2, 1}; pg8::StaticOrder S; S.init(M_TOK, DM, G, bx, FFN2_WGM);
            EpiResid<false, false, true> E{nullptr, XB, ssq_end, nullptr, nullptr};
            pg8::gemm_phase<EpiResid<false, false, true>, pg8::StaticOrder>(lds, g, S, E);
            } else {
            pg8::Gemm g{ACT, (const bf16*)(wb + WB_D), M_TOK, DM, DFF, 64, DFF, 1}; pg8::StaticOrder S; S.init(M_TOK, DM, G, bx, FFN2_WGM);
            EpiResid<false, false> E{nullptr, XB, ssq_end, nullptr, nullptr};
            pg8::gemm_phase<EpiResid<false, false>, pg8::StaticOrder>(lds, g, S, E);
            }
        }
        SEAM(pb + 7);
    }
    if (IN(17)) { LANEVARS();
        float pscale = 1.0f;
        job_final(a.out, XB, SSQX + 3 * M_TOK, a.in[I_FNG], gw, NGW, lane, pscale);
    }
#undef IN
#undef LANEVARS
#undef SEAM
#undef GRID_BAR
}

extern "C" void kernel_launch(void* const* d_in, const int* in_sizes, int n_in, void* d_out, int out_size, void* d_ws, size_t ws_size, hipStream_t stream) {
    static int grid = 0;
    if (grid == 0) {
        if (n_in != 21 || in_sizes[0] != M_TOK * DM || out_size != M_TOK * DM || ws_size < WS_END) {
            fprintf(stderr, "kernel_launch: unexpected problem (n_in %d, in0 %d, out %d, ws %zu; need ws >= %zu); nothing launched\n", n_in, n_in > 0 ? in_sizes[0] : -1, out_size, ws_size, (size_t)WS_END); grid = -1; return; }
        int dev = 0, cus = 0;
        if (hipGetDevice(&dev) != hipSuccess || hipDeviceGetAttribute(&cus, hipDeviceAttributeMultiprocessorCount, dev) != hipSuccess) { grid = -1; return; }
        if (hipFuncSetAttribute((const void*)hymba_fwd, hipFuncAttributeMaxDynamicSharedMemorySize, LDS_BYTES) != hipSuccess) { fprintf(stderr, "kernel_launch: hipFuncSetAttribute failed\n"); grid = -1; return; }
        int per_cu = 0;
        if (hipOccupancyMaxActiveBlocksPerMultiprocessor(&per_cu, (const void*)hymba_fwd, 512, LDS_BYTES) != hipSuccess || per_cu < 1) fprintf(stderr, "kernel_launch: occupancy query says %d blocks per CU\n", per_cu);
        (void)hipGetLastError();
        grid = cus;
    }
    if (grid < 0) return;
    if (hipMemsetAsync((char*)d_ws + WS_CTL, 0, CTL_ZERO_BYTES, stream) != hipSuccess) return;
    Args a{};
    for (int i = 0; i < 21; ++i) a.in[i] = (const float*)d_in[i];
    a.out = (float*)d_out; a.ws = (unsigned char*)d_ws;
#if MK_MULTI
#ifndef MK_STOP
#define MK_STOP NPHASE
#endif
    for (int ph = 0; ph < MK_STOP; ++ph) { a.ph_lo = ph; a.ph_hi = ph + 1; hipLaunchKernelGGL(hymba_fwd, dim3(grid), dim3(512), LDS_BYTES, stream, a); }
#else
    a.ph_lo = 0; a.ph_hi = NPHASE;
    hipLaunchKernelGGL(hymba_fwd, dim3(grid), dim3(512), LDS_BYTES, stream, a);
#endif
}
```

```cpp
#include <hip/hip_runtime.h>
#include <cstdio>
#include <cstdint>

#ifndef MK_MULTI
#define MK_MULTI 0
#endif

#define LAS __attribute__((address_space(3)))
#define GAS __attribute__((address_space(1)))
typedef unsigned short bf16;
typedef short bf16x8 __attribute__((ext_vector_type(8)));
typedef short s16x4 __attribute__((ext_vector_type(4)));
typedef float f32x2 __attribute__((ext_vector_type(2)));
typedef float f32x4 __attribute__((ext_vector_type(4)));
typedef float f32x16 __attribute__((ext_vector_type(16)));
typedef unsigned u32x2 __attribute__((ext_vector_type(2)));
typedef unsigned u32x4 __attribute__((ext_vector_type(4)));
typedef int i32x4 __attribute__((ext_vector_type(4)));
typedef int i32x8 __attribute__((ext_vector_type(8)));

constexpr int SEQ = 2048, NB = 8, M_TOK = NB * SEQ, DM = 4096, DFF = 11008, NGV = 2 * DFF, NINP = 9472  , NHEAD = 8;
constexpr float EPS = 1e-6f;
constexpr float L2E = 1.4426950408889634f;

__device__ __forceinline__ unsigned cvt_pk_bf16(float lo, float hi) { unsigned r; asm volatile("v_cvt_pk_bf16_f32 %0, %1, %2" : "=v"(r) : "v"(lo), "v"(hi)); return r; }
__device__ __forceinline__ float bf2f(unsigned short b) { return __uint_as_float(((unsigned)b) << 16); }
__device__ __forceinline__ unsigned short f2bf(float f) { unsigned u = __float_as_uint(f); return (unsigned short)((u + 0x7fffu + ((u >> 16) & 1u)) >> 16); }
__device__ __forceinline__ float wave_sum(float v) {
#pragma unroll
    for (int o = 1; o < 64; o <<= 1) v += __shfl_xor(v, o);
    return v;
}
__device__ __forceinline__ float gelu_tanh(float x) {
    const float t = x * x, u2 = x * (2.302208198f + 0.1029432327f * t);
    return x * __builtin_amdgcn_rcpf(1.0f + __builtin_amdgcn_exp2f(-u2));
}
typedef unsigned long long u64;
__device__ __forceinline__ void ssq_add(u64* p, float s) { atomicAdd(p, (u64)__float2ull_rz(s * 4294967296.0f)); }
__device__ __forceinline__ float ssq_get(const u64* p) { return __ull2float_rn(*p) * 2.3283064365386963e-10f; }
__device__ __forceinline__ unsigned pk4_fp8(float a, float b, float c, float d) {
    a = __builtin_amdgcn_fmed3f(a, -448.f, 448.f); b = __builtin_amdgcn_fmed3f(b, -448.f, 448.f); c = __builtin_amdgcn_fmed3f(c, -448.f, 448.f); d = __builtin_amdgcn_fmed3f(d, -448.f, 448.f);
    int p = __builtin_amdgcn_cvt_pk_fp8_f32(a, b, 0, false); p = __builtin_amdgcn_cvt_pk_fp8_f32(c, d, p, true); return (unsigned)p; }
#ifndef FP8_LAYERS
#define FP8_LAYERS 2
#endif
#ifndef FP8_FFN1
#define FP8_FFN1 2
#endif
constexpr float X_SCALE = 4.0f, WG_SCALE = 64.0f;
constexpr float ACT_SCALE = 4.0f, WD_SCALE = 128.0f;
__device__ __forceinline__ float silu_f(float x) { return x * __builtin_amdgcn_rcpf(1.0f + __builtin_amdgcn_exp2f(-x * L2E)); }

namespace pg8 {
typedef unsigned short bf16_t;
constexpr int BM = 256, BK = 64, HALF = 128, HTB = HALF * BK * 2, STAGE_BYTES = 8 * HTB, NXCD = 8, WGM = 8;
__host__ __device__ __forceinline__ int lds_byte(int r, int c) { const int st = (r >> 4) * 2 + (c >> 5), rr = r & 15, cc = c & 31, ob = rr * 64 + cc * 2; return st * 1024 + (ob ^ (((ob >> 9) & 1) << 5)); }
__host__ __device__ __forceinline__ void stage_rc(int b, int& R, int& C) { const int st = b / 1024, sb = b % 1024, swz = sb ^ (((sb >> 9) & 1) << 5); R = (st >> 1) * 16 + swz / 64; C = (st & 1) * 32 + (swz % 64) / 2; }
__host__ __device__ __forceinline__ int perm32(int rho) { const int n = rho >> 4, i = rho & 15; return 8 * (i >> 2) + 4 * n + (i & 3); }
struct Unit { int pm, pn; };
struct Gemm { const bf16_t* A; const bf16_t* Bt; int M, N, K, lda, ldb; int blockedA; };
struct StaticOrder {
    int nM, nN, nwg, G, c, wgm;
    __host__ __device__ void init(int M, int N, int G_, int c_, int wgm_ = WGM) { nM = M / BM; nN = N / BM; nwg = nM * nN; G = G_; c = c_; wgm = wgm_; }
    __host__ __device__ bool next(int i, Unit& u) const {
        const long L = (long)i * G + c; if (L >= nwg) return false;
        int wgid = (int)L; { const int q = nwg / NXCD, r = nwg % NXCD, xcd = wgid % NXCD, off = wgid / NXCD; wgid = (xcd < r ? xcd * (q + 1) : r * (q + 1) + (xcd - r) * q) + off; }
        const int nig = wgm * nN, gid = wgid / nig, fm = gid * wgm, gsz = (nM - fm) < wgm ? (nM - fm) : wgm;
        u.pm = fm + ((wgid % nig) % gsz); u.pn = (wgid % nig) / gsz; return true;
    }
    __device__ __forceinline__ void a_ready(const Unit&) const {}
    __device__ __forceinline__ void done(const Unit&) const {}
};

template <class Epi, class Sched, bool ALIGN_EPI = true, bool SP2 = true>
__device__ __forceinline__ void gemm_phase(LAS unsigned char* lds, const Gemm g, const Sched& S, const Epi& E) {
    int tid = threadIdx.x; asm volatile("" : "+v"(tid));
    const int wid = __builtin_amdgcn_readfirstlane(tid >> 6), lane = tid & 63, wr = wid >> 2, wc = wid & 3, fr = lane & 15, fq = lane >> 4;
    int K = g.K; asm volatile("" : "+s"(K));
    const int nt = K / BK;
    unsigned voffA[2], voffB[2];
#pragma unroll
    for (int i = 0; i < 2; ++i) { int R, C; stage_rc(tid * 16 + i * 8192, R, C); const int Rb = Epi::PERM ? ((R & ~31) + perm32(R & 31)) : R;
        voffA[i] = (unsigned)(R * g.lda + C) * 2u; voffB[i] = (unsigned)(Rb * g.ldb + C) * 2u; }
    const size_t kstep = (size_t)(BK * 2);
    const size_t kstepA = g.blockedA ? (size_t)(BM * BK * 2) : kstep;
    const size_t hstepA = (size_t)HALF * g.lda * 2, hstepB = (size_t)HALF * g.ldb * 2;
    const size_t tstepA = g.blockedA ? (size_t)nt * (BM * BK * 2) : 2 * hstepA, tstepB = 2 * hstepB;
    const unsigned ldsw = (unsigned)wid * 1024u;
    const int aoff = lds_byte(wr * 64 + fr, fq * 8), boff = lds_byte(wc * 32 + fr, fq * 8);
#define PG8_SA(b, h) (((b) * 2 + (h)) * HTB)
#define PG8_SB(b, h) ((4 + (b) * 2 + (h)) * HTB)
#define PG8_STAGE(bufoff, gbase, voff) do { _Pragma("unroll") for (int _i = 0; _i < 2; ++_i) \
        __builtin_amdgcn_global_load_lds((const unsigned*)((const char*)(gbase) + (voff)[_i]), (LAS unsigned*)(lds + (bufoff) + ldsw + _i * 8192), 16, 0, 0); } while (0)
#define PG8_LDA(dst, b, h) do { _Pragma("unroll") for (int m = 0; m < 4; ++m) _Pragma("unroll") for (int k = 0; k < 2; ++k) dst[m][k] = *(const LAS bf16x8*)(lds + PG8_SA(b, h) + aoff + m * 2048 + k * 1024); } while (0)
#define PG8_LDB(dst, b, h) do { _Pragma("unroll") for (int n = 0; n < 2; ++n) _Pragma("unroll") for (int k = 0; k < 2; ++k) dst[n][k] = *(const LAS bf16x8*)(lds + PG8_SB(b, h) + boff + n * 2048 + k * 1024); } while (0)
#define PG8_MMA(ai, bj, At, Bt) do { __builtin_amdgcn_s_setprio(1); \
        if constexpr (Epi::FP8) { _Pragma("unroll") for (int m = 0; m < 4; ++m) _Pragma("unroll") for (int n = 0; n < 2; ++n) { \
            const i32x8 b8 = __builtin_shufflevector(__builtin_bit_cast(i32x4, Bt[n][0]), __builtin_bit_cast(i32x4, Bt[n][1]), 0, 1, 2, 3, 4, 5, 6, 7); \
            const i32x8 a8 = __builtin_shufflevector(__builtin_bit_cast(i32x4, At[m][0]), __builtin_bit_cast(i32x4, At[m][1]), 0, 1, 2, 3, 4, 5, 6, 7); \
            asm volatile("v_mfma_scale_f32_16x16x128_f8f6f4 %0, %1, %2, %0, %3, %3 op_sel_hi:[0,0,0]" : "+v"(acc[ai][bj][m][n]) : "v"(b8), "v"(a8), "v"(mxs)); } } \
        else { _Pragma("unroll") for (int m = 0; m < 4; ++m) _Pragma("unroll") for (int n = 0; n < 2; ++n) _Pragma("unroll") for (int k = 0; k < 2; ++k) \
            acc[ai][bj][m][n] = __builtin_amdgcn_mfma_f32_16x16x32_bf16(Bt[n][k], At[m][k], acc[ai][bj][m][n], 0, 0, 0); } \
        __builtin_amdgcn_s_setprio(0); } while (0)
#define PG8_WAIT_V(n) asm volatile("s_waitcnt vmcnt(" #n ")" ::: "memory")
#define PG8_WAIT_L(n) asm volatile("s_waitcnt lgkmcnt(" #n ")" ::: "memory")
#define PG8_BAR __builtin_amdgcn_s_barrier()
#define PG8_SCHED __builtin_amdgcn_sched_barrier(0)
    Unit cur, nxt; int ui = 0;
    if (!S.next(0, cur)) return;
    int mxs = 0x7F7F7F7F; asm volatile("" : "+v"(mxs));
    f32x4 acc[2][2][4][2];
#pragma unroll
    for (int a = 0; a < 2; ++a)
#pragma unroll
        for (int b = 0; b < 2; ++b)
#pragma unroll
            for (int m = 0; m < 4; ++m)
#pragma unroll
                for (int n = 0; n < 2; ++n) acc[a][b][m][n] = (f32x4){0.f, 0.f, 0.f, 0.f};
    bf16x8 At[4][2], B0[2][2], B1[2][2];
    const char* cA = (const char*)g.A + (size_t)cur.pm * tstepA; const char* cB = (const char*)g.Bt + (size_t)cur.pn * tstepB;
    S.a_ready(cur);
    if constexpr (Epi::KHOOK) E.prep(cur, tid);
    if constexpr (SP2) {
        PG8_STAGE(PG8_SB(0, 0), cB, voffB); PG8_STAGE(PG8_SB(0, 1), cB + hstepB, voffB); PG8_STAGE(PG8_SA(0, 0), cA, voffA); PG8_STAGE(PG8_SA(0, 1), cA + hstepA, voffA);
        if (wr == 1) PG8_BAR;
        PG8_WAIT_V(2); PG8_BAR;
        PG8_STAGE(PG8_SB(1, 0), cB + kstep, voffB); PG8_STAGE(PG8_SA(1, 0), cA + kstepA, voffA); PG8_STAGE(PG8_SB(1, 1), cB + hstepB + kstep, voffB);
        PG8_WAIT_V(6); PG8_BAR;
    } else {
        PG8_STAGE(PG8_SB(0, 0), cB, voffB); PG8_STAGE(PG8_SA(0, 0), cA, voffA); PG8_STAGE(PG8_SB(0, 1), cB + hstepB, voffB); PG8_STAGE(PG8_SA(0, 1), cA + hstepA, voffA);
        if (wr == 1) PG8_BAR;
        PG8_WAIT_V(4); PG8_BAR;
        PG8_STAGE(PG8_SB(1, 0), cB + kstep, voffB); PG8_STAGE(PG8_SA(1, 0), cA + kstepA, voffA); PG8_STAGE(PG8_SB(1, 1), cB + hstepB + kstep, voffB);
        PG8_WAIT_V(6); PG8_BAR;
    }
    for (;;) {
        const bool has_next = S.next(ui + 1, nxt);
        const char* nA = has_next ? (const char*)g.A + (size_t)nxt.pm * tstepA : cA; const char* nB = has_next ? (const char*)g.Bt + (size_t)nxt.pn * tstepB : cB;
        if constexpr (Epi::KHOOK) {
#pragma unroll 1
        for (int tg = 0; tg < nt; tg += 16) {
            if (tg != 0) E.khook(acc, cur, tg, wr, fr);
            const int te = (tg + 16 < nt) ? tg + 16 : nt;
#pragma unroll 1
            for (int t = tg; t < te; t += 2) {
            const bool last = (t == nt - 2);
            const char* a1 = cA + (size_t)(t + 1) * kstepA;
            const char* a2 = last ? nA : cA + (size_t)(t + 2) * kstepA; const char* b2 = last ? nB : cB + (size_t)(t + 2) * kstep;
            const char* a3 = a2 + kstepA; const char* b3 = b2 + kstep;
            if (last && has_next) S.a_ready(nxt);
            if constexpr (SP2) {
            PG8_LDB(B0, 0, 0); PG8_LDB(B1, 0, 1); PG8_SCHED; PG8_LDA(At, 0, 0); PG8_STAGE(PG8_SA(1, 1), a1 + hstepA, voffA);
            PG8_WAIT_V(8); PG8_WAIT_L(0); PG8_BAR; PG8_MMA(0, 0, At, B0); PG8_MMA(0, 1, At, B1); PG8_BAR; PG8_SCHED;
            PG8_LDA(At, 0, 1); PG8_STAGE(PG8_SB(0, 0), b2, voffB); PG8_STAGE(PG8_SB(0, 1), b2 + hstepB, voffB); PG8_STAGE(PG8_SA(0, 0), a2, voffA);
            PG8_WAIT_V(8); PG8_WAIT_L(0); PG8_BAR; PG8_MMA(1, 0, At, B0); PG8_MMA(1, 1, At, B1); PG8_BAR; PG8_SCHED;
            PG8_LDB(B0, 1, 0); PG8_LDB(B1, 1, 1); PG8_SCHED; PG8_LDA(At, 1, 0); PG8_STAGE(PG8_SA(0, 1), a2 + hstepA, voffA);
            PG8_WAIT_V(8); PG8_WAIT_L(0); PG8_BAR; PG8_MMA(0, 0, At, B0); PG8_MMA(0, 1, At, B1); PG8_BAR; PG8_SCHED;
            PG8_LDA(At, 1, 1); PG8_STAGE(PG8_SB(1, 0), b3, voffB); PG8_STAGE(PG8_SB(1, 1), b3 + hstepB, voffB); PG8_STAGE(PG8_SA(1, 0), a3, voffA);
            PG8_WAIT_V(8); PG8_WAIT_L(0); PG8_BAR; PG8_MMA(1, 0, At, B0); PG8_MMA(1, 1, At, B1); PG8_BAR; PG8_SCHED;
            } else {
            PG8_LDB(B0, 0, 0); PG8_SCHED; PG8_LDA(At, 0, 0); PG8_STAGE(PG8_SA(1, 1), a1 + hstepA, voffA);
            PG8_WAIT_L(8); PG8_BAR; PG8_WAIT_L(0); PG8_MMA(0, 0, At, B0); PG8_BAR; PG8_SCHED;
            PG8_LDB(B1, 0, 1); PG8_STAGE(PG8_SB(0, 0), b2, voffB);
            PG8_BAR; PG8_WAIT_L(0); PG8_MMA(0, 1, At, B1); PG8_BAR;
            PG8_LDA(At, 0, 1); PG8_STAGE(PG8_SA(0, 0), a2, voffA);
            PG8_BAR; PG8_WAIT_L(0); PG8_MMA(1, 0, At, B0); PG8_BAR; PG8_SCHED;
            PG8_STAGE(PG8_SB(0, 1), b2 + hstepB, voffB);
            PG8_WAIT_V(6); PG8_BAR; PG8_MMA(1, 1, At, B1); PG8_BAR;
            PG8_LDB(B0, 1, 0); PG8_SCHED; PG8_LDA(At, 1, 0); PG8_STAGE(PG8_SA(0, 1), a2 + hstepA, voffA);
            PG8_WAIT_L(8); PG8_BAR; PG8_WAIT_L(0); PG8_MMA(0, 0, At, B0); PG8_BAR; PG8_SCHED;
            PG8_LDB(B1, 1, 1); PG8_STAGE(PG8_SB(1, 0), b3, voffB);
            PG8_BAR; PG8_WAIT_L(0); PG8_MMA(0, 1, At, B1); PG8_BAR;
            PG8_LDA(At, 1, 1); PG8_STAGE(PG8_SA(1, 0), a3, voffA);
            PG8_BAR; PG8_WAIT_L(0); PG8_MMA(1, 0, At, B0); PG8_BAR; PG8_SCHED;
            PG8_STAGE(PG8_SB(1, 1), b3 + hstepB, voffB);
            PG8_WAIT_V(6); PG8_BAR; PG8_MMA(1, 1, At, B1); PG8_BAR;
            }
            }
        }
        } else {
#pragma unroll 1
        for (int t = 0; t < nt; t += 2) {
            const bool last = (t == nt - 2);
            const char* a1 = cA + (size_t)(t + 1) * kstepA;
            const char* a2 = last ? nA : cA + (size_t)(t + 2) * kstepA; const char* b2 = last ? nB : cB + (size_t)(t + 2) * kstep;
            const char* a3 = a2 + kstepA; const char* b3 = b2 + kstep;
            if (last && has_next) S.a_ready(nxt);
            if constexpr (SP2) {
            PG8_LDB(B0, 0, 0); PG8_LDB(B1, 0, 1); PG8_SCHED; PG8_LDA(At, 0, 0); PG8_STAGE(PG8_SA(1, 1), a1 + hstepA, voffA);
            PG8_WAIT_V(8); PG8_WAIT_L(0); PG8_BAR; PG8_MMA(0, 0, At, B0); PG8_MMA(0, 1, At, B1); PG8_BAR; PG8_SCHED;
            PG8_LDA(At, 0, 1); PG8_STAGE(PG8_SB(0, 0), b2, voffB); PG8_STAGE(PG8_SB(0, 1), b2 + hstepB, voffB); PG8_STAGE(PG8_SA(0, 0), a2, voffA);
            PG8_WAIT_V(8); PG8_WAIT_L(0); PG8_BAR; PG8_MMA(1, 0, At, B0); PG8_MMA(1, 1, At, B1); PG8_BAR; PG8_SCHED;
            PG8_LDB(B0, 1, 0); PG8_LDB(B1, 1, 1); PG8_SCHED; PG8_LDA(At, 1, 0); PG8_STAGE(PG8_SA(0, 1), a2 + hstepA, voffA);
            PG8_WAIT_V(8); PG8_WAIT_L(0); PG8_BAR; PG8_MMA(0, 0, At, B0); PG8_MMA(0, 1, At, B1); PG8_BAR; PG8_SCHED;
            PG8_LDA(At, 1, 1); PG8_STAGE(PG8_SB(1, 0), b3, voffB); PG8_STAGE(PG8_SB(1, 1), b3 + hstepB, voffB); PG8_STAGE(PG8_SA(1, 0), a3, voffA);
            PG8_WAIT_V(8); PG8_WAIT_L(0); PG8_BAR; PG8_MMA(1, 0, At, B0); PG8_MMA(1, 1, At, B1); PG8_BAR; PG8_SCHED;
            } else {
            PG8_LDB(B0, 0, 0); PG8_SCHED; PG8_LDA(At, 0, 0); PG8_STAGE(PG8_SA(1, 1), a1 + hstepA, voffA);
            PG8_WAIT_L(8); PG8_BAR; PG8_WAIT_L(0); PG8_MMA(0, 0, At, B0); PG8_BAR; PG8_SCHED;
            PG8_LDB(B1, 0, 1); PG8_STAGE(PG8_SB(0, 0), b2, voffB);
            PG8_BAR; PG8_WAIT_L(0); PG8_MMA(0, 1, At, B1); PG8_BAR;
            PG8_LDA(At, 0, 1); PG8_STAGE(PG8_SA(0, 0), a2, voffA);
            PG8_BAR; PG8_WAIT_L(0); PG8_MMA(1, 0, At, B0); PG8_BAR; PG8_SCHED;
            PG8_STAGE(PG8_SB(0, 1), b2 + hstepB, voffB);
            PG8_WAIT_V(6); PG8_BAR; PG8_MMA(1, 1, At, B1); PG8_BAR;
            PG8_LDB(B0, 1, 0); PG8_SCHED; PG8_LDA(At, 1, 0); PG8_STAGE(PG8_SA(0, 1), a2 + hstepA, voffA);
            PG8_WAIT_L(8); PG8_BAR; PG8_WAIT_L(0); PG8_MMA(0, 0, At, B0); PG8_BAR; PG8_SCHED;
            PG8_LDB(B1, 1, 1); PG8_STAGE(PG8_SB(1, 0), b3, voffB);
            PG8_BAR; PG8_WAIT_L(0); PG8_MMA(0, 1, At, B1); PG8_BAR;
            PG8_LDA(At, 1, 1); PG8_STAGE(PG8_SA(1, 0), a3, voffA);
            PG8_BAR; PG8_WAIT_L(0); PG8_MMA(1, 0, At, B0); PG8_BAR; PG8_SCHED;
            PG8_STAGE(PG8_SB(1, 1), b3 + hstepB, voffB);
            PG8_WAIT_V(6); PG8_BAR; PG8_MMA(1, 1, At, B1); PG8_BAR;
            }
        }
        }
        if constexpr (ALIGN_EPI) { if (wr == 0) PG8_BAR; }
        if constexpr (Epi::FP8) asm volatile("s_nop 15\n\ts_nop 7" ::: "memory");
        E(acc, cur, wr, wc, fr, fq);
        if (!has_next) break;
#pragma unroll
        for (int a = 0; a < 2; ++a)
#pragma unroll
            for (int b = 0; b < 2; ++b)
#pragma unroll
                for (int m = 0; m < 4; ++m)
#pragma unroll
                    for (int n = 0; n < 2; ++n) acc[a][b][m][n] = (f32x4){0.f, 0.f, 0.f, 0.f};
        cur = nxt; cA = nA; cB = nB; ++ui;
        if constexpr (ALIGN_EPI) { if (wr == 1) PG8_BAR; }
    }
    PG8_WAIT_V(0);
    if constexpr (!ALIGN_EPI) { if (wr == 0) PG8_BAR; }
    PG8_BAR;
#undef PG8_SA
#undef PG8_SB
#undef PG8_STAGE
#undef PG8_LDA
#undef PG8_LDB
#undef PG8_MMA
#undef PG8_WAIT_V
#undef PG8_WAIT_L
#undef PG8_BAR
#undef PG8_SCHED
}
}
template <int SITE> struct EpiProj {
    static constexpr bool PERM = true, KHOOK = false, FP8 = false;
    bf16* O; int ldc; const u64* ssq_in; float inv_dim; u64* ssq_o1; u64* ssq_o2; const float* rope; float* flog;
    __device__ __forceinline__ void operator()(const f32x4 (&acc)[2][2][4][2], const pg8::Unit& u, int wr, int wc, int fr, int fq) const {
        int mode = 0;
        if (SITE == 0) { const int pn = u.pn; mode = (pn >= 12 && pn < 20) ? 1 : (pn >= 20 && pn < 23) ? 2 : (pn == 23) ? 3 : 0; }
        if (SITE == 1) mode = (u.pn >= 4) ? 4 : 0;
        const int row0 = u.pm * 256 + wr * 64 + fr, col0 = u.pn * 256 + wc * 32 + 8 * fq;
#pragma unroll
        for (int ai = 0; ai < 2; ++ai)
#pragma unroll
            for (int m = 0; m < 4; ++m) {
                const int row = row0 + ai * 128 + m * 16;
                const float rs = __builtin_amdgcn_rsqf(ssq_get(ssq_in + row) * inv_dim + EPS);
                f32x4 v0[2], v1[2];
#pragma unroll
                for (int bj = 0; bj < 2; ++bj) { v0[bj] = acc[ai][bj][m][0] * rs; v1[bj] = acc[ai][bj][m][1] * rs; }
                if (mode == 1) {
#pragma unroll
                    for (int bj = 0; bj < 2; ++bj)
#pragma unroll
                        for (int e = 0; e < 4; ++e) { v0[bj][e] = gelu_tanh(v0[bj][e]); v1[bj][e] = gelu_tanh(v1[bj][e]); }
                }
                if (mode == 2 || mode == 3) {
                    float s = 0.f;
#pragma unroll
                    for (int bj = 0; bj < 2; ++bj)
#pragma unroll
                        for (int e = 0; e < 4; ++e) s += v0[bj][e] * v0[bj][e] + v1[bj][e] * v1[bj][e];
                    s += __shfl_xor(s, 16); s += __shfl_xor(s, 32);
                    if (fq == 0) ssq_add((mode == 2 ? ssq_o1 : ssq_o2) + row, s);
                }
                if (mode == 4) {
                    const int pos = row & (SEQ - 1);
                    const float* rp = rope + (size_t)pos * 64 + 16 * (wc & 1) + 4 * fq;
                    const f32x4 cs = *(const f32x4*)rp, sn = *(const f32x4*)(rp + 32);
#pragma unroll
                    for (int bj = 0; bj < 2; ++bj) {
                        const f32x4 a = v0[bj], b = v1[bj]; v0[bj] = a * cs - b * sn; v1[bj] = b * cs + a * sn;
                    }
                }
                bf16* rowp = O + (size_t)row * ldc + col0;
#pragma unroll
                for (int bj = 0; bj < 2; ++bj) {
                    u32x4 w; w.x = cvt_pk_bf16(v0[bj][0], v0[bj][1]); w.y = cvt_pk_bf16(v0[bj][2], v0[bj][3]); w.z = cvt_pk_bf16(v1[bj][0], v1[bj][1]); w.w = cvt_pk_bf16(v1[bj][2], v1[bj][3]);
                    *(u32x4*)(rowp + bj * 128) = w; }
            }
    }
};
struct EpiPart {
    static constexpr bool PERM = true, KHOOK = false, FP8 = false;
    float* part;
    __device__ __forceinline__ void operator()(const f32x4 (&acc)[2][2][4][2], const pg8::Unit& u, int wr, int wc, int fr, int fq) const {
        if (wc < 2 || (wc == 2 && fq == 0)) {
            const int row0 = u.pm * 256 + wr * 64 + fr, c0 = wc * 32 + 8 * fq;
#pragma unroll
            for (int ai = 0; ai < 2; ++ai)
#pragma unroll
                for (int m = 0; m < 4; ++m) { float* p = part + (size_t)(row0 + ai * 128 + m * 16) * 72 + c0;
                    *(f32x4*)p = acc[ai][0][m][0]; *(f32x4*)(p + 4) = acc[ai][0][m][1]; }
        }
    }
};
struct EpiNull { static constexpr bool PERM = true, KHOOK = false, FP8 = false; float* sink;
    __device__ __forceinline__ void operator()(const f32x4 (&acc)[2][2][4][2], const pg8::Unit& u, int wr, int wc, int fr, int fq) const {
        f32x4 s = acc[0][0][0][0];
#pragma unroll
        for (int ai = 0; ai < 2; ++ai)
#pragma unroll
            for (int bj = 0; bj < 2; ++bj)
#pragma unroll
                for (int m = 0; m < 4; ++m)
#pragma unroll
                    for (int n = 0; n < 2; ++n) s = s + acc[ai][bj][m][n];
        if (s[0] + s[1] + s[2] + s[3] == 12345.678f) sink[0] = 1.f; } };
struct OneUnit { int pm, pn;
    __device__ __forceinline__ bool next(int i, pg8::Unit& u) const { if (i != 0) return false; u.pm = pm; u.pn = pn; return true; }
    __device__ __forceinline__ void a_ready(const pg8::Unit&) const {}
    __device__ __forceinline__ void done(const pg8::Unit&) const {} };
template <bool F32IN, bool GNORM, bool F8 = false> struct EpiResid {
    static constexpr bool PERM = true, KHOOK = GNORM, FP8 = F8;
    const float* resid32; bf16* xb; u64* ssq; const u64* ssqy; LAS float* tbl; unsigned char* xb8;
    __device__ __forceinline__ void prep(const pg8::Unit& u, int tid) const {
        if (tid < 256) { const u64* sp = ssqy + (size_t)(u.pm * 256 + tid) * 4; float r[4];
#pragma unroll
            for (int g = 0; g < 4; ++g) r[g] = __builtin_amdgcn_rsqf(ssq_get(sp + g) * (1.0f / 1024.0f) + EPS);
            *(LAS f32x4*)(tbl + tid * 4) = (f32x4){r[0] * __builtin_amdgcn_rcpf(r[1]), r[1] * __builtin_amdgcn_rcpf(r[2]), r[2] * __builtin_amdgcn_rcpf(r[3]), r[3]}; }
        asm volatile("s_waitcnt lgkmcnt(0)" ::: "memory");
    }
    __device__ __forceinline__ void khook(f32x4 (&acc)[2][2][4][2], const pg8::Unit& u, int t, int wr, int fr) const {
        const int g = t >> 4, rl0 = wr * 64 + fr;
#pragma unroll
        for (int ai = 0; ai < 2; ++ai)
#pragma unroll
            for (int m = 0; m < 4; ++m) { const float ratio = tbl[(rl0 + ai * 128 + m * 16) * 4 + g - 1];
#pragma unroll
                for (int bj = 0; bj < 2; ++bj)
#pragma unroll
                    for (int n = 0; n < 2; ++n) acc[ai][bj][m][n] = acc[ai][bj][m][n] * ratio; }
    }
    __device__ __forceinline__ void operator()(const f32x4 (&acc)[2][2][4][2], const pg8::Unit& u, int wr, int wc, int fr, int fq) const {
        asm volatile("" : "+v"(fr), "+v"(fq));
        const int row0 = u.pm * 256 + wr * 64 + fr, col0 = u.pn * 256 + wc * 32 + 8 * fq;
        f32x4 rb[3][4];
#define ER_LOAD(k) do { const size_t off_ = (size_t)(row0 + ((k) >> 2) * 128 + ((k) & 3) * 16) * DM + col0; \
        if constexpr (F32IN) { rb[(k) % 3][0] = *(const f32x4*)(resid32 + off_); rb[(k) % 3][1] = *(const f32x4*)(resid32 + off_ + 4); rb[(k) % 3][2] = *(const f32x4*)(resid32 + off_ + 128); rb[(k) % 3][3] = *(const f32x4*)(resid32 + off_ + 132); } \
        else { _Pragma("unroll") for (int b_ = 0; b_ < 2; ++b_) { const u32x4 t_ = *(const u32x4*)(xb + off_ + b_ * 128); \
                 rb[(k) % 3][2 * b_] = (f32x4){__uint_as_float(t_.x << 16), __uint_as_float(t_.x & 0xffff0000u), __uint_as_float(t_.y << 16), __uint_as_float(t_.y & 0xffff0000u)}; \
                 rb[(k) % 3][2 * b_ + 1] = (f32x4){__uint_as_float(t_.z << 16), __uint_as_float(t_.z & 0xffff0000u), __uint_as_float(t_.w << 16), __uint_as_float(t_.w & 0xffff0000u)}; } } } while (0)
        ER_LOAD(0); ER_LOAD(1);
#pragma unroll
        for (int k = 0; k < 8; ++k) {
            const int ai = k >> 2, m = k & 3;
            if (k + 2 < 8) ER_LOAD(k + 2);
            const int row = row0 + ai * 128 + m * 16; const size_t off = (size_t)row * DM + col0; float s = 0.f;
            const float r3 = GNORM ? tbl[(wr * 64 + fr + ai * 128 + m * 16) * 4 + 3] : (F8 ? 1.0f / (ACT_SCALE * WD_SCALE) : 1.0f);
#pragma unroll
            for (int bj = 0; bj < 2; ++bj) {
                const f32x4 v0 = rb[k % 3][bj * 2] + acc[ai][bj][m][0] * r3, v1 = rb[k % 3][bj * 2 + 1] + acc[ai][bj][m][1] * r3;
                u32x4 w; w.x = cvt_pk_bf16(v0[0], v0[1]); w.y = cvt_pk_bf16(v0[2], v0[3]); w.z = cvt_pk_bf16(v1[0], v1[1]); w.w = cvt_pk_bf16(v1[2], v1[3]);
                *(u32x4*)(xb + off + bj * 128) = w;
                if (xb8) { u32x2 q; q.x = pk4_fp8(v0[0] * X_SCALE, v0[1] * X_SCALE, v0[2] * X_SCALE, v0[3] * X_SCALE); q.y = pk4_fp8(v1[0] * X_SCALE, v1[1] * X_SCALE, v1[2] * X_SCALE, v1[3] * X_SCALE);
                    *(u32x2*)(xb8 + off + bj * 128) = q; }
                s += ((v0[0] * v0[0] + v0[1] * v0[1]) + (v0[2] * v0[2] + v0[3] * v0[3])) + ((v1[0] * v1[0] + v1[1] * v1[1]) + (v1[2] * v1[2] + v1[3] * v1[3]));
            }
            s += __shfl_xor(s, 16); s += __shfl_xor(s, 32);
            if (fq == 0) ssq_add(ssq + row, s);
            __builtin_amdgcn_sched_barrier(0);
        }
#undef ER_LOAD
    }
};
__device__ __forceinline__ float dpp_ror1(float v) { return __builtin_bit_cast(float, __builtin_amdgcn_mov_dpp(__builtin_bit_cast(int, v), 0x121, 0xF, 0xF, true)); }
__device__ __forceinline__ float dpp_ror2(float v) { return __builtin_bit_cast(float, __builtin_amdgcn_mov_dpp(__builtin_bit_cast(int, v), 0x122, 0xF, 0xF, true)); }
typedef float f32p2 __attribute__((ext_vector_type(2)));
#define F2H(v, h) ((f32p2){(v)[2 * (h)], (v)[2 * (h) + 1]})
template <bool F8, bool F8IN = false>
struct EpiFfn1 {
    static constexpr bool PERM = true, KHOOK = false, FP8 = F8IN;
    static constexpr float QS = F8IN ? 1.0f / (X_SCALE * WG_SCALE) : 1.0f;
    bf16* act; const u64* ssq_in; const float* cw; const float* cb; float* side; LAS float* xch;
    __device__ __forceinline__ void operator()(const f32x4 (&acc)[2][2][4][2], const pg8::Unit& u, int wr, int wc, int fr, int fq) const {
        asm volatile("" : "+v"(fr), "+v"(fq));
        const int wid = wr * 4 + wc;
        const int row0 = u.pm * 256 + wr * 64 + fr, ch0 = u.pn * 128 + wc * 32 + 8 * fq;
        f32x4 w0[2], w1[2], w2[2], bb[2];
#pragma unroll
        for (int n = 0; n < 2; ++n) { w0[n] = *(const f32x4*)(cw + ch0 + 4 * n); w1[n] = *(const f32x4*)(cw + DFF + ch0 + 4 * n); w2[n] = *(const f32x4*)(cw + 2 * DFF + ch0 + 4 * n); bb[n] = *(const f32x4*)(cb + ch0 + 4 * n); }
        if (fr >= 14) {
#pragma unroll
            for (int ai = 0; ai < 2; ++ai) {
                const float rs = __builtin_amdgcn_rsqf(ssq_get(ssq_in + row0 + ai * 128 + 48) * (1.0f / DM) + EPS) * QS;
                LAS float* xp = xch + ((wid * 2 + ai) * 2 + (fr - 14)) * 32 + 8 * fq;
                *(LAS f32x4*)xp = acc[ai][0][3][0] * rs; *(LAS f32x4*)(xp + 4) = acc[ai][0][3][1] * rs;
            }
        }
        asm volatile("s_waitcnt lgkmcnt(0)" ::: "memory"); __builtin_amdgcn_s_barrier(); asm volatile("" ::: "memory");
#pragma unroll
        for (int ai = 0; ai < 2; ++ai) {
            f32x4 xa[2], xb_[2];
            const bool have = (wr == 1) || (ai == 1);
            { const int sw = (wr == 1) ? wc : 4 + wc, sai = (wr == 1) ? ai : 0;
              const LAS float* xp = xch + ((sw * 2 + sai) * 2) * 32 + 8 * fq;
#pragma unroll
              for (int n = 0; n < 2; ++n) { xa[n] = have ? *(const LAS f32x4*)(xp + 4 * n) : (f32x4){0.f, 0.f, 0.f, 0.f}; xb_[n] = have ? *(const LAS f32x4*)(xp + 32 + 4 * n) : (f32x4){0.f, 0.f, 0.f, 0.f}; } }
            f32x4 gprev[2];
#pragma unroll
            for (int m = 0; m < 4; ++m) {
                const int row = row0 + ai * 128 + m * 16;
                const float rs = __builtin_amdgcn_rsqf(ssq_get(ssq_in + row) * (1.0f / DM) + EPS) * QS;
                f32x4 g[2], vv[2], o[2];
#pragma unroll
                for (int n = 0; n < 2; ++n) { g[n] = acc[ai][0][m][n] * rs; vv[n] = acc[ai][1][m][n] * rs; }
#pragma unroll
                for (int n = 0; n < 2; ++n)
#pragma unroll
                    for (int h = 0; h < 2; ++h) {
                        const f32p2 g2 = F2H(g[n], h), gp = (m == 0) ? ((fr == 14) ? F2H(xa[n], h) : F2H(xb_[n], h)) : F2H(gprev[n], h);
                        const f32p2 t1 = (fr == 15) ? gp : g2, t2 = (fr >= 14) ? gp : g2;
                        const f32p2 p1 = {dpp_ror1(t1.x), dpp_ror1(t1.y)}, p2 = {dpp_ror2(t2.x), dpp_ror2(t2.y)};
                        const f32p2 gate = F2H(bb[n], h) + F2H(w0[n], h) * p2 + F2H(w1[n], h) * p1 + F2H(w2[n], h) * g2;
                        const f32p2 en = gate * (-L2E);
                        const f32p2 d = (f32p2){__builtin_amdgcn_exp2f(en.x), __builtin_amdgcn_exp2f(en.y)} + 1.0f;
                        const f32p2 r = {__builtin_amdgcn_rcpf(d.x), __builtin_amdgcn_rcpf(d.y)};
                        const f32p2 o2 = (gate * r) * F2H(vv[n], h);
                        o[n][2 * h] = o2.x; o[n][2 * h + 1] = o2.y;
                    }
                if constexpr (F8) {
                u32x2 w; w.x = pk4_fp8(o[0][0] * ACT_SCALE, o[0][1] * ACT_SCALE, o[0][2] * ACT_SCALE, o[0][3] * ACT_SCALE); w.y = pk4_fp8(o[1][0] * ACT_SCALE, o[1][1] * ACT_SCALE, o[1][2] * ACT_SCALE, o[1][3] * ACT_SCALE);
                *(u32x2*)((unsigned char*)act + (((size_t)(row >> 8) * (DFF / 128) + (ch0 >> 7)) * 256 + (row & 255)) * 128 + (ch0 & 127)) = w;
                } else {
                u32x4 w; w.x = cvt_pk_bf16(o[0][0], o[0][1]); w.y = cvt_pk_bf16(o[0][2], o[0][3]); w.z = cvt_pk_bf16(o[1][0], o[1][1]); w.w = cvt_pk_bf16(o[1][2], o[1][3]);
                *(u32x4*)(act + (((size_t)(row >> 8) * (DFF / 64) + (ch0 >> 6)) * 256 + (row & 255)) * 64 + (ch0 & 63)) = w;
                }
                if (ai == 0 && m == 0 && wr == 0 && fr < 2) {
                    float* sp = side + ((size_t)u.pm * 6 + fr) * DFF + ch0; *(f32x4*)sp = g[0]; *(f32x4*)(sp + 4) = g[1];
                    float* sv = side + ((size_t)u.pm * 6 + 4 + fr) * DFF + ch0; *(f32x4*)sv = vv[0]; *(f32x4*)(sv + 4) = vv[1]; }
                if (ai == 1 && m == 3 && wr == 1 && fr >= 14) {
                    float* sp = side + ((size_t)u.pm * 6 + 2 + (fr - 14)) * DFF + ch0; *(f32x4*)sp = g[0]; *(f32x4*)(sp + 4) = g[1]; }
                gprev[0] = g[0]; gprev[1] = g[1];
            }
        }
    }
};
constexpr size_t MiB = 1u << 20;
constexpr size_t WS_CTL = 0, CTL_ZERO_BYTES = 3 * MiB + 65536;
constexpr int CW_BAR = 4096;
constexpr size_t WS_SSQX = 1 * MiB;
constexpr size_t WS_SSQCQ = WS_SSQX + 4 * 131072;
constexpr size_t WS_SSQCKV = WS_SSQCQ + 2 * 131072;
constexpr size_t WS_SSQY = WS_SSQCKV + 2 * 131072;
constexpr size_t WS_DBG = 3 * MiB;
constexpr size_t WS_SSQX0 = 4 * MiB;
constexpr size_t WS_ROPE = WS_SSQX0 + 131072;
constexpr size_t WS_FLOG = 5 * MiB;
constexpr size_t WS_CUM = WS_FLOG + 512 * 1024;
constexpr size_t WS_KM = 6 * MiB;
constexpr size_t WS_SGUW = WS_KM + 512 * 1024;
constexpr size_t WS_SIDE = 8 * MiB;
constexpr size_t WS_W = 32 * MiB;
constexpr size_t WB_IN = 0, WB_UQ = WB_IN + (size_t)NINP * DM * 2, WB_UKV = WB_UQ + (size_t)1536 * 768 * 2, WB_O = WB_UKV + (size_t)2048 * 256 * 2,
                 WB_GV = WB_O + (size_t)DM * DM * 2, WB_D = WB_GV + (size_t)NGV * DM * 2, WB_LAYER = WB_D + (size_t)DM * DFF * 2;
constexpr size_t WS_XB = 768 * MiB;
constexpr size_t WS_Y = 896 * MiB;
constexpr size_t WS_PROJ = 1024 * MiB;
constexpr size_t WS_MLAQ = 1320 * MiB;
constexpr size_t WS_MLAKV = 1368 * MiB;
constexpr size_t WS_ACT = 1024 * MiB;
constexpr size_t WS_PART = 1432 * MiB;
constexpr size_t WS_END = 1452 * MiB;
static_assert(WS_W + 2 * WB_LAYER <= WS_XB && WS_PROJ + (size_t)M_TOK * NINP * 2 <= WS_MLAQ && WS_ACT + (size_t)M_TOK * DFF * 2 <= WS_PART && WS_PART + (size_t)4 * M_TOK * 72 * 4 <= WS_END && WS_SIDE + (size_t)64 * 6 * DFF * 4 <= WS_W, "ws map");
static_assert(WS_SSQY + 2 * 16384 * 4 * 8 <= WS_DBG && WS_DBG + 65536 <= CTL_ZERO_BYTES && WS_ROPE + 2048 * 64 * 4 <= WS_FLOG, "zero region");

constexpr int RING_BYTES = 131072;
constexpr int XCH_OFF = 133120;
constexpr int MISC_OFF = 140 * 1024;
constexpr int LDS_BYTES = 147456;

#define XB_TMO      128
#define XB_XCNT(j)  (256  + 64 * (j))
#define XB_XSUB(j)  (1280 + 64 * (j))
#define XB_XGEN(j)  (2304 + 64 * (j))
#define XB_TOP      3328
#define XB_TOPGEN   3392
#define XCD_BAR_WORDS 3456
#define XB_SPIN_CAP (1u << 18)
__device__ __forceinline__ unsigned xb_ld(unsigned* p)              { return __hip_atomic_load(p, __ATOMIC_RELAXED, __HIP_MEMORY_SCOPE_AGENT); }
__device__ __forceinline__ unsigned xb_add(unsigned* p, unsigned v) { return __hip_atomic_fetch_add(p, v, __ATOMIC_RELAXED, __HIP_MEMORY_SCOPE_AGENT); }
__device__ __forceinline__ unsigned xb_xcc_id() { return (unsigned)__builtin_amdgcn_s_getreg((3 << 11) | 20) & 0xFu; }
#define XB_SPIN(cond, bar) do { unsigned _sp = 0; while (cond) { __builtin_amdgcn_s_sleep(1); \
    if ((++_sp & 255u) == 0u) { if (xb_ld(&(bar)[XB_TMO])) break; if (_sp > XB_SPIN_CAP) { atomicAdd(&(bar)[XB_TMO], 1u); break; } } } } while (0)
struct XcdBarrier { unsigned* bar; unsigned x; volatile LAS unsigned* st; };
__device__ __forceinline__ XcdBarrier xcd_barrier_post(unsigned* bar, volatile LAS unsigned* st) {
    XcdBarrier b; b.bar = bar; b.x = xb_xcc_id(); b.st = st;
    if (threadIdx.x == 0) (void)xb_add(&bar[XB_XCNT(b.x)], 1u);
    return b;
}
__device__ __forceinline__ void xcd_barrier_complete(unsigned* bar, unsigned x, unsigned& nloc, unsigned& nx) {
    const unsigned G = gridDim.x * gridDim.y * gridDim.z;
    unsigned sum, cnt, mine, sp = 0u;
    for (;;) {
        sum = 0u; cnt = 0u; mine = 0u;
#pragma unroll
        for (unsigned j = 0; j < 16; ++j) { const unsigned c = xb_ld(&bar[XB_XCNT(j)]); sum += c; cnt += (c > 0u) ? 1u : 0u; mine = (j == x) ? c : mine; }
        if (sum == G) break;
        __builtin_amdgcn_s_sleep(1);
        if ((++sp & 255u) == 0u) { if (xb_ld(&bar[XB_TMO])) break; if (sp > XB_SPIN_CAP) { atomicAdd(&bar[XB_TMO], 1u); break; } }
    }
    nloc = mine > 0u ? mine : 1u; nx = cnt > 0u ? cnt : 1u;
}
__device__ __forceinline__ void xcd_barrier(const XcdBarrier& b) {
    asm volatile("s_waitcnt vmcnt(0)" ::: "memory");
    __syncthreads();
    if (threadIdx.x == 0) {
        unsigned* bar = b.bar; asm volatile("" : "+s"(bar));
        __builtin_amdgcn_s_waitcnt(0);
        unsigned nloc = b.st[0], nx = b.st[1];
        if (nloc == 0u) { xcd_barrier_complete(bar, b.x, nloc, nx); b.st[0] = nloc; b.st[1] = nx; }
        const unsigned old = xb_add(&bar[XB_XSUB(b.x)], 1u);
        const unsigned gen = old / nloc;
        if (old + 1u == (gen + 1u) * nloc) {
            __builtin_amdgcn_fence(__ATOMIC_RELEASE, "agent");
            asm volatile("s_waitcnt vmcnt(0)" ::: "memory");
            const unsigned og = xb_add(&bar[XB_TOP], 1u);
            const unsigned tg = og / nx;
            if (og + 1u == (tg + 1u) * nx) xb_add(&bar[XB_TOPGEN], 1u);
            else XB_SPIN(xb_ld(&bar[XB_TOPGEN]) == tg, bar);
            __builtin_amdgcn_fence(__ATOMIC_ACQUIRE, "agent");
            xb_add(&bar[XB_XGEN(b.x)], 1u);
            asm volatile("s_waitcnt vmcnt(0)" ::: "memory");
        } else {
            XB_SPIN(xb_ld(&bar[XB_XGEN(b.x)]) == gen, bar);
            __builtin_amdgcn_fence(__ATOMIC_ACQUIRE, "agent");
            asm volatile("s_waitcnt vmcnt(0)" ::: "memory");
        }
    }
    __syncthreads();
}

struct Args {
    const float* in[21]; float* out; unsigned char* ws; int ph_lo, ph_hi;
};
static_assert(sizeof(Args) == 23 * 8 + 8, "Args has no padding");
enum { I_X = 0, I_NMG, I_WIN, I_LNG, I_LNB, I_SGUW, I_SGUB, I_QNG, I_KVNG, I_WUQ, I_WUKV, I_BF, I_GNG, I_WO, I_NFG, I_WG, I_WV, I_CW, I_CB, I_WD, I_FNG };

__host__ __device__ __forceinline__ int ropeperm(int i) { return (i & 4) ? 32 + 4 * (i >> 3) + (i & 3) : 4 * (i >> 3) + (i & 3); }
struct TrDesc { const float* src; const float* gain; bf16* dst; int ldsrc, scol, mode, nv, k0, K, drow0, f8; float qs; };
constexpr int TR_IN = 64 * 148, TR_UQ = 12 * 24, TR_UKV = 4 * 32, TR_O = 64 * 64, TR_GV = 64 * 344, TR_D = 172 * 64, TR_LAYER = TR_IN + TR_UQ + TR_UKV + TR_O + TR_GV + TR_D;
__device__ __forceinline__ TrDesc tr_desc(const Args& a, int flat) {
    const int l = flat / TR_LAYER; int it = flat - l * TR_LAYER;
    unsigned char* wb = a.ws + WS_W + (size_t)l * WB_LAYER;
    TrDesc d; d.mode = 0; d.nv = 64; d.f8 = 0; d.qs = 1.0f;
    if (it < TR_IN) {
        const int kb = it / 148, j0 = (it % 148) * 64;
        d.src = a.in[I_WIN] + (size_t)l * DM * 9288; d.gain = a.in[I_NMG] + (size_t)l * DM; d.dst = (bf16*)(wb + WB_IN); d.ldsrc = 9288; d.k0 = kb * 64; d.K = DM; d.drow0 = j0;
        if (j0 < 6144) d.scol = j0; else if (j0 < 9216) d.scol = j0 + 64; else if (j0 == 9216) { d.scol = 6144; d.mode = 1; } else if (j0 == 9280) { d.scol = 9280; d.nv = 8; } else { d.scol = 0; d.nv = 0; }
        return d; }
    it -= TR_IN;
    if (it < TR_UQ) {
        const int kb = it / 24, j0 = (it % 24) * 64;
        d.src = a.in[I_WUQ] + (size_t)l * 768 * 1536; d.gain = a.in[I_QNG] + (size_t)l * 768; d.dst = (bf16*)(wb + WB_UQ); d.ldsrc = 1536; d.k0 = kb * 64; d.K = 768; d.drow0 = j0;
        if (j0 < 1024) d.scol = (j0 >> 7) * 192 + (j0 & 127); else { d.scol = ((j0 - 1024) >> 6) * 192 + 128; d.mode = 1; }
        return d; }
    it -= TR_UQ;
    if (it < TR_UKV) {
        const int kb = it / 32, j0 = (it % 32) * 64, jj = j0 & 1023;
        d.src = a.in[I_WUKV] + (size_t)l * 256 * 2048; d.gain = a.in[I_KVNG] + (size_t)l * 256; d.dst = (bf16*)(wb + WB_UKV); d.ldsrc = 2048; d.k0 = kb * 64; d.K = 256; d.drow0 = j0;
        d.scol = (jj >> 7) * 256 + (jj & 127) + ((j0 >= 1024) ? 128 : 0);
        return d; }
    it -= TR_UKV;
    if (it < TR_O) {
        const int kb = it / 64, j0 = (it % 64) * 64;
        d.src = a.in[I_WO] + (size_t)l * DM * DM; d.gain = a.in[I_GNG] + (size_t)l * DM; d.dst = (bf16*)(wb + WB_O); d.ldsrc = DM; d.k0 = kb * 64; d.K = DM; d.drow0 = j0; d.scol = j0;
        return d; }
    it -= TR_O;
    if (it < TR_GV) {
        const int kb = it / 344, j0 = (it % 344) * 64, t = j0 >> 8, w = j0 & 255;
        d.src = ((w < 128) ? a.in[I_WG] : a.in[I_WV]) + (size_t)l * DM * DFF; d.gain = a.in[I_NFG] + (size_t)l * DM; d.dst = (bf16*)(wb + WB_GV); d.ldsrc = DFF; d.k0 = kb * 64; d.K = DM; d.drow0 = j0;
        d.scol = t * 128 + (w & 127); d.f8 = (FP8_FFN1 >> l) & 1; d.qs = d.f8 ? WG_SCALE : 1.0f;
        return d; }
    it -= TR_GV;
    {
        const int kb = it / 64, j0 = (it % 64) * 64;
        d.src = a.in[I_WD] + (size_t)l * DFF * DM; d.gain = nullptr; d.dst = (bf16*)(wb + WB_D); d.ldsrc = DM; d.k0 = kb * 64; d.K = DFF; d.drow0 = j0; d.scol = j0; d.f8 = (FP8_LAYERS >> l) & 1; d.qs = d.f8 ? WD_SCALE : 1.0f;
        return d; }
}
__device__ __forceinline__ void tr_load(const TrDesc& d, int lane, f32x4 (&v)[16], float (&gn)[16]) {
    asm volatile("" : "+v"(lane));
    const int g4 = lane & 15, kr = lane >> 4, j0 = 4 * g4;
    const int col = d.scol + (d.mode ? ropeperm(j0) : j0);
    const bool valid = j0 < d.nv;
#pragma unroll
    for (int it = 0; it < 16; ++it) { const int kk = 4 * it + kr;
        v[it] = valid ? *(const f32x4*)(d.src + (size_t)(d.k0 + kk) * d.ldsrc + col) : (f32x4){0.f, 0.f, 0.f, 0.f};
        gn[it] = (d.gain ? d.gain[d.k0 + kk] : 1.0f) * d.qs; }
}
__device__ __forceinline__ void tr_store(const TrDesc& d, int lane, const f32x4 (&v)[16], const float (&gn)[16], LAS float* scr) {
    asm volatile("" : "+v"(lane));
    const int g4 = lane & 15, kr = lane >> 4, j0 = 4 * g4;
#pragma unroll
    for (int it = 0; it < 16; ++it) { const int kk = 4 * it + kr; const f32x4 w = v[it] * gn[it];
        LAS float* p = scr + kk * 65 + j0; p[0] = w[0]; p[1] = w[1]; p[2] = w[2]; p[3] = w[3]; }
    asm volatile("s_waitcnt lgkmcnt(0)" ::: "memory");
    const int c = lane & 7;
    if (d.f8) {
#pragma unroll
        for (int j = 0; j < 8; ++j) {
            const int n = (lane >> 3) + 8 * j; const LAS float* s = scr + (8 * c) * 65 + n;
            u32x2 o; o.x = pk4_fp8(s[0], s[65], s[2 * 65], s[3 * 65]); o.y = pk4_fp8(s[4 * 65], s[5 * 65], s[6 * 65], s[7 * 65]);
            *(u32x2*)((unsigned char*)d.dst + (size_t)(d.drow0 + n) * d.K + d.k0 + 8 * c) = o;
        }
    } else {
#pragma unroll
    for (int j = 0; j < 8; ++j) {
        const int n = (lane >> 3) + 8 * j; const LAS float* s = scr + (8 * c) * 65 + n;
        u32x4 o; o.x = cvt_pk_bf16(s[0], s[65]); o.y = cvt_pk_bf16(s[2 * 65], s[3 * 65]); o.z = cvt_pk_bf16(s[4 * 65], s[5 * 65]); o.w = cvt_pk_bf16(s[6 * 65], s[7 * 65]);
        *(u32x4*)(d.dst + (size_t)(d.drow0 + n) * d.K + d.k0 + 8 * c) = o;
    }
    }
    asm volatile("s_waitcnt lgkmcnt(0)" ::: "memory");
}
__device__ __forceinline__ void prologue_weights(const Args& a, int lo, int hi, LAS float* scr, int gw, int NGW, int lane) {
    int cur = lo + gw;
    if (cur >= hi) return;
    f32x4 v[16], vn[16]; float gn[16], gnn[16];
    TrDesc d = tr_desc(a, cur); tr_load(d, lane, v, gn);
    for (;;) {
        const int nxt = cur + NGW; const bool more = nxt < hi;
        TrDesc dn = d;
        if (more) { dn = tr_desc(a, nxt); tr_load(dn, lane, vn, gnn); }
        tr_store(d, lane, v, gn, scr);
        if (!more) break;
#pragma unroll
        for (int i = 0; i < 16; ++i) { v[i] = vn[i]; gn[i] = gnn[i]; }
        d = dn; cur = nxt;
    }
}
__device__ __forceinline__ void prologue_misc(const Args& a, int gw, int NGW, int lane, int gtid, int NT) {
    { const float* X = a.in[I_X]; bf16* XB = (bf16*)(a.ws + WS_XB); u64* S0 = (u64*)(a.ws + WS_SSQX0);
      for (int r = gw; r < M_TOK; r += NGW) { const f32x4* xr = (const f32x4*)(X + (size_t)r * DM) + lane; u32x2* o = (u32x2*)(XB + (size_t)r * DM) + lane; float s = 0.f;
          f32x4 vv[16];
#pragma unroll
          for (int j = 0; j < 16; ++j) vv[j] = xr[64 * j];
#pragma unroll
          for (int j = 0; j < 16; ++j) { const f32x4 v = vv[j]; s += (v[0] * v[0] + v[1] * v[1]) + (v[2] * v[2] + v[3] * v[3]); u32x2 w; w.x = cvt_pk_bf16(v[0], v[1]); w.y = cvt_pk_bf16(v[2], v[3]); o[64 * j] = w; }
          s = wave_sum(s); if (lane == 0) S0[r] = (u64)__float2ull_rz(s * 4294967296.0f); } }
    { float* R = (float*)(a.ws + WS_ROPE);
      for (int i = gtid; i < SEQ * 32; i += NT) { const int pos = i >> 5, j = i & 31; const double ang = (double)pos * pow(10000.0, -(double)j / 32.0); R[pos * 64 + j] = (float)cos(ang); R[pos * 64 + 32 + j] = (float)sin(ang); } }
    { const float* W = a.in[I_SGUW]; bf16* D = (bf16*)(a.ws + WS_SGUW);
      for (int i = gtid; i < 2 * 8 * 128 * 128; i += NT) { const int s = i & 127, t = (i >> 7) & 127; D[i] = (s <= t) ? f2bf(W[i]) : (bf16)0; } }
}
__device__ __forceinline__ s16x4 vtr(const LAS unsigned char* p) { return __builtin_bit_cast(s16x4, __builtin_amdgcn_ds_read_tr16_b64_v4i16((LAS s16x4*)p)); }
__device__ __forceinline__ bf16x8 cat4(s16x4 lo, s16x4 hi) { return (bf16x8){lo[0], lo[1], lo[2], lo[3], hi[0], hi[1], hi[2], hi[3]}; }
__device__ __forceinline__ float xmax32(float v) { const auto rr = __builtin_amdgcn_permlane32_swap(__float_as_uint(v), __float_as_uint(v), false, false); return fmaxf(__uint_as_float(rr[0]), __uint_as_float(rr[1])); }
__device__ __forceinline__ float xsum32(float v) { const auto rr = __builtin_amdgcn_permlane32_swap(__float_as_uint(v), __float_as_uint(v), false, false); return __uint_as_float(rr[0]) + __uint_as_float(rr[1]); }
__device__ __forceinline__ int crow(int r, int hi) { return (r & 3) + 8 * (r >> 2) + 4 * hi; }

__device__ __forceinline__ void job_kmean(const bf16* proj, float* km, int item, LAS unsigned char* lds) {
    int tid = threadIdx.x; asm volatile("" : "+v"(tid));
    const int b = item >> 6, h = (item >> 3) & 7, n = item & 7;
    const int ch = tid & 15, rs = tid >> 4;
    const bf16* kp = proj + ((size_t)(b * SEQ + n * 256 + rs)) * NINP + 1024 + h * 128 + ch * 8;
    float acc[8];
#pragma unroll
    for (int e = 0; e < 8; ++e) acc[e] = 0.f;
#pragma unroll
    for (int it = 0; it < 8; ++it) { const u32x4 v = *(const u32x4*)(kp + (size_t)(32 * it) * NINP);
#pragma unroll
        for (int e = 0; e < 4; ++e) { acc[2 * e] += __uint_as_float(v[e] << 16); acc[2 * e + 1] += __uint_as_float(v[e] & 0xffff0000u); } }
    LAS float* sc = (LAS float*)lds;
#pragma unroll
    for (int e = 0; e < 8; ++e) sc[rs * 128 + ch * 8 + e] = acc[e];
    __syncthreads();
    if (tid < 128) { float s = 0.f;
#pragma unroll 8
        for (int r = 0; r < 32; ++r) s += sc[r * 128 + tid];
        km[(size_t)item * 128 + tid] = s * (1.0f / 256.0f); }
    __syncthreads();
}
__device__ __forceinline__ void job_cum(const float* part, const u64* ssq_in, const float* bfp, float* cum, int item, LAS unsigned char* lds) {
    int tid = threadIdx.x; asm volatile("" : "+v"(tid));
    const int lane = tid & 63, wid = tid >> 6;
    const int b = item >> 3, h = item & 7; const float bias = bfp[h];
    const size_t r0 = (size_t)b * SEQ + tid * 4;
    const float* fp = part + r0 * 72 + 64 + h;
    float v[4]; float run = 0.f;
#pragma unroll
    for (int i = 0; i < 4; ++i) {
        const float raw = (fp[(size_t)i * 72] + fp[(size_t)i * 72 + (size_t)M_TOK * 72]) + (fp[(size_t)i * 72 + (size_t)2 * M_TOK * 72] + fp[(size_t)i * 72 + (size_t)3 * M_TOK * 72]);
        const float z = raw * __builtin_amdgcn_rsqf(ssq_get(ssq_in + r0 + i) * (1.0f / DM) + EPS) + bias;
        const float lf = fminf(z, 0.f) - log1pf(expf(-fabsf(z))); run += lf; v[i] = run; }
    float incl = run;
#pragma unroll
    for (int o = 1; o < 64; o <<= 1) { const float t = __shfl_up(incl, o); if (lane >= o) incl += t; }
    LAS float* wt = (LAS float*)lds;
    if (lane == 63) wt[wid] = incl;
    __syncthreads();
    float base = 0.f;
#pragma unroll
    for (int w = 0; w < 8; ++w) base += (w < wid) ? wt[w] : 0.f;
    const float excl = base + incl - run;
    *(f32x4*)(cum + (size_t)item * SEQ + tid * 4) = (f32x4){v[0] + excl, v[1] + excl, v[2] + excl, v[3] + excl};
    __syncthreads();
}
__device__ __forceinline__ void job_krope(const float* part, const u64* ssq_in, const float* rope, bf16* proj, int gtid, int NT) {
    for (int i = gtid; i < M_TOK * 8; i += NT) { const int row = i >> 3, a = i & 7;
        const float* p = part + (size_t)row * 72 + 8 * a;
        f32x4 x1 = *(const f32x4*)p, x2 = *(const f32x4*)(p + 4);
#pragma unroll
        for (int q = 1; q < 4; ++q) { x1 = x1 + *(const f32x4*)(p + (size_t)q * M_TOK * 72); x2 = x2 + *(const f32x4*)(p + (size_t)q * M_TOK * 72 + 4); }
        const float rs = __builtin_amdgcn_rsqf(ssq_get(ssq_in + row) * (1.0f / DM) + EPS);
        x1 = x1 * rs; x2 = x2 * rs;
        const float* rp = rope + (size_t)(row & (SEQ - 1)) * 64 + 4 * a;
        const f32x4 cs = *(const f32x4*)rp, sn = *(const f32x4*)(rp + 32);
        const f32x4 o1 = x1 * cs - x2 * sn, o2 = x2 * cs + x1 * sn;
        u32x4 w; w.x = cvt_pk_bf16(o1[0], o1[1]); w.y = cvt_pk_bf16(o1[2], o1[3]); w.z = cvt_pk_bf16(o2[0], o2[1]); w.w = cvt_pk_bf16(o2[2], o2[3]);
        *(u32x4*)(proj + (size_t)row * NINP + 9216 + 8 * a) = w; }
}
constexpr int VP = 320;
constexpr int UP = 272;
template <int CTRL, int ROWMASK = 0xF> __device__ __forceinline__ float dppmov(float v) { return __builtin_bit_cast(float, __builtin_amdgcn_update_dpp(0, __builtin_bit_cast(int, v), CTRL, ROWMASK, 0xF, false)); }
__device__ __forceinline__ float row16_allsum(float s) { s += dppmov<0x128>(s); s += dppmov<0x124>(s); s += dppmov<0x122>(s); s += dppmov<0x121>(s); return s; }
__device__ __forceinline__ float half32_sum_hi16(float s) { s = row16_allsum(s); return s + dppmov<0x142, 0xA>(s); }
struct SguRegs { u32x4 v[4], u[4]; };
__device__ __forceinline__ void sgu_load(SguRegs& R, const bf16* proj, int item, int tid) {
    const int b = item >> 7, c = (item >> 3) & 15, g = item & 7, ch = tid & 15, rs = tid >> 4;
    const bf16* p = proj + ((size_t)b * SEQ + c * 128 + rs) * NINP + g * 128 + ch * 8;
#pragma unroll
    for (int q = 0; q < 4; ++q) { R.v[q] = *(const u32x4*)(p + (size_t)(32 * q) * NINP + 4096); R.u[q] = *(const u32x4*)(p + (size_t)(32 * q) * NINP + 3072); }
}
#define LDS_BARRIER() do { asm volatile("s_waitcnt lgkmcnt(0)" ::: "memory"); __builtin_amdgcn_s_barrier(); asm volatile("" ::: "memory"); } while (0)
__device__ __forceinline__ void job_sgu_stream(const Args& a, int l, int first, int stride, int nitems, LAS unsigned char* lds, bool dummy = false) {
    int tid = threadIdx.x; asm volatile("" : "+v"(tid));
    const int wid = __builtin_amdgcn_readfirstlane(tid >> 6), lane = tid & 63, r32 = lane & 31, hi = lane >> 5;
    const bf16* proj = (const bf16*)(a.ws + WS_PROJ);
    bf16* Y = (bf16*)(a.ws + (dummy ? WS_END : WS_Y)); u64* ssq = dummy ? (u64*)(a.ws + WS_END + 128 * MiB) : (u64*)(a.ws + WS_SSQY) + (size_t)l * M_TOK * 4;
    const int ch = tid & 15, rs = tid >> 4, rg = wid & 3, dh = wid >> 2, t = 32 * rg + r32;
    LAS unsigned char* VT = lds;
    if (first >= nitems) return;
    SguRegs R; sgu_load(R, proj, first, tid);
    int par = 0;
    for (int item = first; item < nitems; item += stride, par ^= 1) {
        const int b = item >> 7, c = (item >> 3) & 15, g = item & 7;
        const size_t R0 = (size_t)b * SEQ + c * 128;
        LAS unsigned char* UT = lds + 40960 + par * (128 * UP);
        const float* lng = a.in[I_LNG] + (size_t)(l * 8 + g) * 128; const float* lnb = a.in[I_LNB] + (size_t)(l * 8 + g) * 128;
        const bf16* wp = (const bf16*)(a.ws + WS_SGUW) + ((size_t)((l * 8 + g) * 128 + t)) * 128 + hi * 8;
        bf16x8 af[8];
#pragma unroll
        for (int ks = 0; ks < 8; ++ks) af[ks] = *(const bf16x8*)(wp + ks * 16);
        { const f32x4 g0 = *(const f32x4*)(lng + ch * 8), g1 = *(const f32x4*)(lng + ch * 8 + 4), b0 = *(const f32x4*)(lnb + ch * 8), b1 = *(const f32x4*)(lnb + ch * 8 + 4);
#pragma unroll
          for (int p = 0; p < 4; ++p) { const int row = rs + 32 * p; const u32x4 v = R.v[p];
              float x[8];
#pragma unroll
              for (int e = 0; e < 4; ++e) { x[2 * e] = __uint_as_float(v[e] << 16); x[2 * e + 1] = __uint_as_float(v[e] & 0xffff0000u); }
              float s = 0.f;
#pragma unroll
              for (int e = 0; e < 8; ++e) s += x[e];
              const float mean = row16_allsum(s) * (1.0f / 128.0f); float q = 0.f;
#pragma unroll
              for (int e = 0; e < 8; ++e) { x[e] -= mean; q += x[e] * x[e]; }
              const float rstd = __builtin_amdgcn_rsqf(row16_allsum(q) * (1.0f / 128.0f) + EPS);
              u32x4 w; w.x = cvt_pk_bf16(x[0] * rstd * g0[0] + b0[0], x[1] * rstd * g0[1] + b0[1]); w.y = cvt_pk_bf16(x[2] * rstd * g0[2] + b0[2], x[3] * rstd * g0[3] + b0[3]);
              w.z = cvt_pk_bf16(x[4] * rstd * g1[0] + b1[0], x[5] * rstd * g1[1] + b1[1]); w.w = cvt_pk_bf16(x[6] * rstd * g1[2] + b1[2], x[7] * rstd * g1[3] + b1[3]);
              *(LAS u32x4*)(VT + row * VP + ch * 16) = w;
              *(LAS u32x4*)(UT + row * UP + ch * 16) = R.u[p]; } }
        if (item + stride < nitems) sgu_load(R, proj, item + stride, tid);
        LDS_BARRIER();
        f32x16 o[2];
#pragma unroll
        for (int dd = 0; dd < 2; ++dd)
#pragma unroll
            for (int r = 0; r < 16; ++r) o[dd][r] = 0.f;
        const LAS unsigned char* vb = VT + (8 * (lane >> 5) + ((lane & 15) >> 2)) * VP + (16 * ((lane >> 4) & 1) + 4 * (lane & 3)) * 2;
#pragma unroll
        for (int ks = 0; ks < 8; ++ks) {
            if (ks < 2 * rg + 2) {
#pragma unroll
                for (int dd = 0; dd < 2; ++dd) { const int d0 = 2 * dh + dd;
                    const s16x4 lo = vtr(vb + (16 * ks) * VP + d0 * 64), hh = vtr(vb + (16 * ks + 4) * VP + d0 * 64);
                    o[dd] = __builtin_amdgcn_mfma_f32_32x32x16_bf16(af[ks], cat4(lo, hh), o[dd], 0, 0, 0); } }
        }
        const float* bs = a.in[I_SGUB] + (size_t)(l * 8 + g) * 128;
#pragma unroll
        for (int r = 0; r < 16; ++r) { const int tt = 32 * rg + crow(r, hi); const float bt = bs[tt]; float ss = 0.f;
#pragma unroll
            for (int dd = 0; dd < 2; ++dd) { const int col = (2 * dh + dd) * 32 + r32;
                LAS unsigned short* up = (LAS unsigned short*)(UT + tt * UP) + col;
                const float v = (o[dd][r] + bt) * bf2f(*up); ss += v * v;
                const float vn = dppmov<0xB1>(v);
                if ((r32 & 1) == 0) *(LAS unsigned*)up = cvt_pk_bf16(v, vn); }
            ss = half32_sum_hi16(ss);
            if (r32 == 16) ssq_add(ssq + (R0 + tt) * 4 + 1, ss); }
        LDS_BARRIER();
#pragma unroll
        for (int p = 0; p < 4; ++p) { const int row = rs + 32 * p;
            *(u32x4*)(Y + (R0 + row) * DM + 1024 + g * 128 + ch * 8) = *(const LAS u32x4*)(UT + row * UP + ch * 16); }
    }
    LDS_BARRIER();
}

namespace att {
constexpr int KBUF = 25600, VBUF = 64 * VP, OFF_K = 0, OFF_V = 2 * KBUF, OFF_KM = OFF_V + 2 * VBUF, OFF_C = OFF_KM + 32 * 272, OFF_W = OFF_C + 512, LDS_USED = OFF_W + 8 * 64 * 4;
static_assert(LDS_USED <= RING_BYTES, "attention LDS");
struct P { const bf16* Qn; int ldq; const bf16* Qr; int ldqr; const bf16* Kn; int ldk; const bf16* Kr; int ldkr; const bf16* V; int ldv; const float* km; const float* cum; bf16* Y; u64* ssq; int grp; };

template <int MODE, int EXPV = 0> __device__ __forceinline__ void attn_block(const P& p, int b, int h, int qb, LAS unsigned char* lds) {
    constexpr int DK = (MODE == 1) ? 192 : 128, ND = DK / 16, KP = DK * 2 + 16;
    constexpr float SCALE = (MODE == 1) ? 0.07216878364870322f : 0.08838834764831845f;
    constexpr float C2 = SCALE * L2E, THR = 6.0f, NEG = -__builtin_inff();
    int tid = threadIdx.x; asm volatile("" : "+v"(tid));
    const int wid = __builtin_amdgcn_readfirstlane(tid >> 6), lane = tid & 63, r32 = lane & 31, hi = lane >> 5;
    const int q0 = qb * 256 + wid * 32, trow = q0 + r32;
    const size_t rb = (size_t)b * SEQ;
    bf16x8 qr[ND];
    { const bf16* qp = p.Qn + (rb + trow) * p.ldq + h * 128 + hi * 8;
#pragma unroll
      for (int d0 = 0; d0 < 8; ++d0) qr[d0] = *(const bf16x8*)(qp + d0 * 16);
      if constexpr (MODE == 1) { const bf16* qp2 = p.Qr + (rb + trow) * p.ldqr + h * 64 + hi * 8;
#pragma unroll
          for (int d0 = 0; d0 < 4; ++d0) qr[8 + d0] = *(const bf16x8*)(qp2 + d0 * 16); } }
    const int srow = tid >> 4, sch = tid & 15, rrow = tid >> 3, rch = tid & 7;
    const bf16* kg = p.Kn + rb * p.ldk + h * 128 + sch * 8;
    const bf16* vg = p.V + rb * p.ldv + h * 128 + sch * 8;
    const bf16* krg = (MODE == 1) ? p.Kr + rb * p.ldkr + rch * 8 : nullptr;
    const float* cg = (MODE == 2) ? p.cum + ((size_t)(b * 8 + h)) * SEQ : nullptr;
    u32x4 sk0, sk1, sv0, sv1, skr; float scv = 0.f;
#define ATT_LOAD(j) do { const size_t k0_ = (size_t)(j) * 64; sk0 = *(const u32x4*)(kg + (k0_ + srow) * p.ldk); sk1 = *(const u32x4*)(kg + (k0_ + srow + 32) * p.ldk); \
        sv0 = *(const u32x4*)(vg + (k0_ + srow) * p.ldv); sv1 = *(const u32x4*)(vg + (k0_ + srow + 32) * p.ldv); \
        if constexpr (MODE == 1) skr = *(const u32x4*)(krg + (k0_ + rrow) * p.ldkr); \
        if constexpr (MODE == 2) { if (tid < 64) scv = cg[k0_ + tid]; } } while (0)
#define ATT_WRITE(bf) do { LAS unsigned char* kb_ = lds + OFF_K + (bf) * KBUF; LAS unsigned char* vb_ = lds + OFF_V + (bf) * VBUF; \
        *(LAS u32x4*)(kb_ + srow * KP + sch * 16) = sk0; *(LAS u32x4*)(kb_ + (srow + 32) * KP + sch * 16) = sk1; \
        *(LAS u32x4*)(vb_ + srow * VP + sch * 16) = sv0; *(LAS u32x4*)(vb_ + (srow + 32) * VP + sch * 16) = sv1; \
        if constexpr (MODE == 1) *(LAS u32x4*)(kb_ + rrow * KP + 256 + rch * 16) = skr; \
        if constexpr (MODE == 2) { if (tid < 64) ((LAS float*)(lds + OFF_C))[(bf) * 64 + tid] = scv; } } while (0)
    const int nt = (EXPV & 32) ? 1 : 4 * (qb + 1);
    ATT_LOAD(0);
    unsigned selmask = 0u; float slope2 = 0.f;
    if constexpr (MODE == 0) {
        slope2 = __builtin_amdgcn_exp2f(-(float)(h + 1)) * L2E;
        const f32x2 x = *(const f32x2*)(p.km + ((size_t)(b * 8 + h)) * 1024 + 2 * tid);
        const int n = tid >> 6, d = (2 * tid) & 127;
        const unsigned short h0 = f2bf(x[0]), h1 = f2bf(x[1]); const unsigned short l0 = f2bf(x[0] - bf2f(h0)), l1 = f2bf(x[1] - bf2f(h1));
        *(LAS unsigned*)(lds + OFF_KM + n * 272 + d * 2) = (unsigned)h0 | ((unsigned)h1 << 16);
        *(LAS unsigned*)(lds + OFF_KM + (8 + n) * 272 + d * 2) = (unsigned)l0 | ((unsigned)l1 << 16);
        for (int i = tid; i < 1088; i += 512) ((LAS unsigned*)(lds + OFF_KM + 16 * 272))[i] = 0u;
    }
    ATT_WRITE(0);
    if (nt > 1) ATT_LOAD(1);
    LDS_BARRIER();
    if constexpr (MODE == 0) {
        f32x16 g;
#pragma unroll
        for (int r = 0; r < 16; ++r) g[r] = 0.f;
        const LAS unsigned char* ka = lds + OFF_KM + r32 * 272 + hi * 16;
#pragma unroll
        for (int d0 = 0; d0 < 8; ++d0) g = __builtin_amdgcn_mfma_f32_32x32x16_bf16(*(const LAS bf16x8*)(ka + d0 * 32), qr[d0], g, 0, 0, 0);
        float gv[8];
#pragma unroll
        for (int r = 0; r < 4; ++r) { const float own = g[r] + g[4 + r], oth = __shfl_xor(own, 32); gv[r] = hi ? oth : own; gv[4 + r] = hi ? own : oth; }
#pragma unroll
        for (int n = 0; n < 8; ++n) if (n >= qb) gv[n] = NEG;
#pragma unroll
        for (int n = 0; n < 8; ++n) { int rank = 0;
#pragma unroll
            for (int m = 0; m < 8; ++m) if (m != n) rank += ((gv[m] > gv[n]) || (gv[m] == gv[n] && m < n)) ? 1 : 0;
            if (n < qb && rank < 3) selmask |= 1u << n; }
    }
    float crl = 0.f;
    if constexpr (MODE == 2) crl = cg[trow] * L2E;
    float m_reg = -128.f, l_reg = 0.f;
    float bc[16];
#pragma unroll
    for (int r = 0; r < 16; ++r) bc[r] = (MODE == 0) ? slope2 * (float)((r & 3) + 8 * (r >> 2)) : 0.f;
    f32x16 o[4];
#pragma unroll
    for (int d0 = 0; d0 < 4; ++d0)
#pragma unroll
        for (int r = 0; r < 16; ++r) o[d0][r] = 0.f;
    LAS float* al = (LAS float*)(lds + OFF_W) + wid * 64;
    for (int j = 0; j < nt; ++j) {
        const int bf = j & 1, kb = j * 64;
        if (j + 1 < nt) { ATT_WRITE(bf ^ 1); if (j + 2 < nt) ATT_LOAD(j + 2); }
        if (kb <= q0 + 31) {
#pragma unroll
          for (int hf = 0; hf < 2; ++hf) {
            const int kh = kb + 32 * hf;
            if (kh > q0 + 31) break;
            f32x16 p0;
#pragma unroll
            for (int r = 0; r < 16; ++r) p0[r] = 0.f;
            { const LAS unsigned char* ka = lds + OFF_K + bf * KBUF + (32 * hf + r32) * KP + hi * 16;
#pragma unroll
              for (int d0 = 0; d0 < ((EXPV & 8) ? 1 : ND); ++d0) {
                  const bf16x8 a0 = *(const LAS bf16x8*)(ka + d0 * 32);
                  p0 = __builtin_amdgcn_mfma_f32_32x32x16_bf16(a0, qr[d0], p0, 0, 0, 0);
                  if ((d0 & 3) == 3) __builtin_amdgcn_sched_barrier(0); } }
            const int dq = trow - kh - 4 * hi;
            if (!(EXPV & 2)) {
            if constexpr (MODE == 0) {
                const int blkn = kb >> 8; const bool sel = (blkn == qb) || ((selmask >> blkn) & 1u);
                const float bm = sel ? (-slope2 * (float)dq - m_reg) : NEG;
#pragma unroll
                for (int r = 0; r < 16; ++r) p0[r] = fmaf(p0[r], C2, bc[r] + bm);
            } else if constexpr (MODE == 1) {
                const float bm = -m_reg;
#pragma unroll
                for (int r = 0; r < 16; ++r) p0[r] = fmaf(p0[r], C2, bm);
            } else {
                const float bm = crl - m_reg;
                const LAS float* cb = (const LAS float*)(lds + OFF_C) + bf * 64 + 32 * hf + 4 * hi;
#pragma unroll
                for (int g4 = 0; g4 < 4; ++g4) { const f32x4 ca = *(const LAS f32x4*)(cb + 8 * g4);
#pragma unroll
                    for (int e = 0; e < 4; ++e) p0[4 * g4 + e] = fmaf(p0[4 * g4 + e], C2, fmaf(ca[e], -L2E, bm)); }
            }
            if (kh + 31 > q0) {
#pragma unroll
                for (int r = 0; r < 16; ++r) { const int c = (r & 3) + 8 * (r >> 2); if (c > dq) p0[r] = NEG; }
            }
            float pm = p0[0];
#pragma unroll
            for (int r = 1; r < 16; ++r) pm = fmaxf(pm, p0[r]);
            pm = xmax32(pm);
            if (__all(pm < -160.f)) continue;
            float alpha = 1.f;
            if (!__all(pm <= THR)) {
                const float d = fmaxf(pm, 0.f); alpha = __builtin_amdgcn_exp2f(-d); m_reg += d;
#pragma unroll
                for (int r = 0; r < 16; ++r) p0[r] -= d; }
            float ps = 0.f;
#pragma unroll
            for (int r = 0; r < 16; ++r) { p0[r] = __builtin_amdgcn_exp2f(p0[r]); ps += p0[r]; }
            ps = xsum32(ps);
            l_reg = l_reg * alpha + ps;
            if (__any(alpha < 1.f)) {
                if (hi == 0) al[r32] = alpha;
                asm volatile("s_waitcnt lgkmcnt(0)" ::: "memory");
#pragma unroll
                for (int g4 = 0; g4 < 4; ++g4) { const f32x4 av = *(const LAS f32x4*)(al + 8 * g4 + 4 * hi);
#pragma unroll
                    for (int d0 = 0; d0 < 4; ++d0)
#pragma unroll
                        for (int e = 0; e < 4; ++e) o[d0][4 * g4 + e] *= av[e]; }
                asm volatile("s_waitcnt lgkmcnt(0)" ::: "memory");
            }
            }
            bf16x8 pa[2];
#pragma unroll
            for (int ks = 0; ks < 2; ++ks) {
                u32x4 w; w.x = cvt_pk_bf16(p0[8 * ks], p0[8 * ks + 1]); w.y = cvt_pk_bf16(p0[8 * ks + 2], p0[8 * ks + 3]); w.z = cvt_pk_bf16(p0[8 * ks + 4], p0[8 * ks + 5]); w.w = cvt_pk_bf16(p0[8 * ks + 6], p0[8 * ks + 7]);
                pa[ks] = __builtin_bit_cast(bf16x8, w); }
            const LAS unsigned char* vb = lds + OFF_V + bf * VBUF + (32 * hf + 4 * (lane >> 5) + ((lane & 15) >> 2)) * VP + (16 * ((lane >> 4) & 1) + 4 * (lane & 3)) * 2;
#pragma unroll
            for (int d0 = 0; d0 < ((EXPV & 4) ? 1 : 4); ++d0) {
#pragma unroll
                for (int ks = 0; ks < 2; ++ks) {
                    const s16x4 lo = vtr(vb + (16 * ks) * VP + d0 * 64), hh = vtr(vb + (16 * ks + 8) * VP + d0 * 64);
                    o[d0] = __builtin_amdgcn_mfma_f32_32x32x16_bf16(pa[ks], cat4(lo, hh), o[d0], 0, 0, 0); }
                if (d0 & 1) __builtin_amdgcn_sched_barrier(0); }
          }
        }
        LDS_BARRIER();
    }
#undef ATT_LOAD
#undef ATT_WRITE
    LAS float* li = al + 32;
    if (hi == 0) li[r32] = l_reg;
    asm volatile("s_waitcnt lgkmcnt(0)" ::: "memory");
#pragma unroll
    for (int g4 = 0; g4 < 4; ++g4) { const f32x4 lv = *(const LAS f32x4*)(li + 8 * g4 + 4 * hi);
#pragma unroll
        for (int e = 0; e < 4; ++e) { const int r = 4 * g4 + e; const float inv = __builtin_amdgcn_rcpf(lv[e]);
            const size_t grow = rb + q0 + crow(r, hi); float ss = 0.f;
#pragma unroll
            for (int d0 = 0; d0 < 4; ++d0) { const float v = o[d0][r] * inv; ss += v * v; const float vn = __shfl_xor(v, 1);
                if ((r32 & 1) == 0) *(unsigned*)(p.Y + grow * DM + p.grp * 1024 + h * 128 + d0 * 32 + r32) = cvt_pk_bf16(v, vn); }
            ss += __shfl_xor(ss, 1); ss += __shfl_xor(ss, 2); ss += __shfl_xor(ss, 4); ss += __shfl_xor(ss, 8); ss += __shfl_xor(ss, 16);
            if (r32 == 0) ssq_add(p.ssq + grow * 4 + p.grp, ss); } }
    asm volatile("s_waitcnt lgkmcnt(0)" ::: "memory");
    __syncthreads();
}
}
__device__ __forceinline__ void job_ynorm(bf16* Y, const u64* ssqy, int gw, int NGW, int lane) {
    for (int r = gw; r < M_TOK; r += NGW) {
        float s4[4];
#pragma unroll
        for (int g = 0; g < 4; ++g) s4[g] = ssq_get(ssqy + (size_t)r * 4 + g);
        u32x4* yp = (u32x4*)(Y + (size_t)r * DM) + lane;
#pragma unroll
        for (int i = 0; i < 8; ++i) { const float rs = __builtin_amdgcn_rsqf(s4[i >> 1] * (1.0f / 1024.0f) + EPS);
            u32x4 v = yp[64 * i];
#pragma unroll
            for (int e = 0; e < 4; ++e) v[e] = cvt_pk_bf16(__uint_as_float(v[e] << 16) * rs, __uint_as_float(v[e] & 0xffff0000u) * rs);
            yp[64 * i] = v; }
    }
}
__device__ __forceinline__ void job_halo(const float* side, const float* cw, const float* cb, bf16* act, int gtid, int NT, bool f8) {
    for (int i = gtid; i < 64 * 2 * (DFF / 4); i += NT) {
        const int c4 = i % (DFF / 4), rr = (i / (DFF / 4)) & 1, pm = i / (2 * (DFF / 4));
        if ((pm & 7) == 0) continue;
        const int c = 4 * c4;
        const f32x4 gm2 = *(const f32x4*)(side + ((size_t)(pm - 1) * 6 + 2 + rr) * DFF + c);
        const f32x4 gm1 = rr ? *(const f32x4*)(side + ((size_t)pm * 6 + 0) * DFF + c) : *(const f32x4*)(side + ((size_t)(pm - 1) * 6 + 3) * DFF + c);
        const f32x4 g0 = *(const f32x4*)(side + ((size_t)pm * 6 + rr) * DFF + c), v = *(const f32x4*)(side + ((size_t)pm * 6 + 4 + rr) * DFF + c);
        const f32x4 w0 = *(const f32x4*)(cw + c), w1 = *(const f32x4*)(cw + DFF + c), w2 = *(const f32x4*)(cw + 2 * DFF + c), bb = *(const f32x4*)(cb + c);
        float o[4];
#pragma unroll
        for (int e = 0; e < 4; ++e) o[e] = silu_f(bb[e] + w0[e] * gm2[e] + w1[e] * gm1[e] + w2[e] * g0[e]) * v[e];
        if (f8) *(unsigned*)((unsigned char*)act + (((size_t)pm * (DFF / 128) + (c >> 7)) * 256 + rr) * 128 + (c & 127)) = pk4_fp8(o[0] * ACT_SCALE, o[1] * ACT_SCALE, o[2] * ACT_SCALE, o[3] * ACT_SCALE);
        else { u32x2 w; w.x = cvt_pk_bf16(o[0], o[1]); w.y = cvt_pk_bf16(o[2], o[3]);
            *(u32x2*)(act + (((size_t)pm * (DFF / 64) + (c >> 6)) * 256 + rr) * 64 + (c & 63)) = w; }
    }
}
__device__ __forceinline__ void job_final(float* out, const bf16* xb, const u64* ssq, const float* g, int gw, int NGW, int lane, float pscale) {
    for (int r = gw; r < M_TOK; r += NGW) {
        const float rs = __builtin_amdgcn_rsqf(ssq_get(ssq + r) * (1.0f / DM) + EPS) * pscale;
        f32x4* op = (f32x4*)(out + (size_t)r * DM) + lane; const f32x4* gp = (const f32x4*)g + lane; const u32x2* xp = (const u32x2*)(xb + (size_t)r * DM) + lane;
        u32x2 tt[16];
#pragma unroll
        for (int j = 0; j < 16; ++j) tt[j] = xp[64 * j];
#pragma unroll
        for (int j = 0; j < 16; ++j) { const u32x2 t = tt[j];
            const f32x4 v = (f32x4){__uint_as_float(t.x << 16), __uint_as_float(t.x & 0xffff0000u), __uint_as_float(t.y << 16), __uint_as_float(t.y & 0xffff0000u)};
            op[64 * j] = v * rs * gp[64 * j]; }
    }
}
#ifndef MK_PROBE_T0
#define MK_PROBE_T0 0
#endif
#ifndef TR_TAIL
#define TR_TAIL 3584
#endif
#ifndef FFN2_WGM
#define FFN2_WGM 2
#endif
constexpr int NPHASE = 18;
__global__ void __launch_bounds__(512, 2) hymba_fwd(Args a) {
    extern __shared__ __attribute__((aligned(16))) unsigned char lds_raw[];
    LAS unsigned char* lds = (LAS unsigned char*)lds_raw;
    volatile LAS unsigned* MISC = (volatile LAS unsigned*)(lds + MISC_OFF);
    const int tid = threadIdx.x;
    const int G = gridDim.x; const int bx = blockIdx.x; const int vcu = (G % 8 == 0) ? (bx % 8) * (G / 8) + bx / 8 : bx;
    const int NGW = G * 8, NT = G * 512;
#define LANEVARS() int tid_ = threadIdx.x; asm volatile("" : "+v"(tid_)); const int lane = tid_ & 63, wave = __builtin_amdgcn_readfirstlane(tid_ >> 6), gw = vcu * 8 + wave, gtid = vcu * 512 + tid_; (void)lane; (void)gw; (void)gtid
    unsigned char* ws = a.ws;
    for (int u = tid; u < 64; u += 512) MISC[u] = 0u;
    __syncthreads();
#if !MK_MULTI
    XcdBarrier bar = xcd_barrier_post((unsigned*)(ws + WS_CTL) + CW_BAR, MISC + 8);
#define GRID_BAR() xcd_barrier(bar)
#else
#define GRID_BAR() do { } while (0)
#endif
    const int lo = a.ph_lo, hi_ = a.ph_hi;
#define IN(k) (lo <= (k) && (k) < hi_)
#define SEAM(k) do { if (IN(k) && IN((k) + 1)) GRID_BAR(); } while (0)
    bf16* XB = (bf16*)(ws + WS_XB); bf16* Y = (bf16*)(ws + WS_Y); bf16* PROJ = (bf16*)(ws + WS_PROJ); bf16* MLAQ = (bf16*)(ws + WS_MLAQ); bf16* MLAKV = (bf16*)(ws + WS_MLAKV); bf16* ACT = (bf16*)(ws + WS_ACT);
    unsigned char* XB8 = ws + WS_MLAKV;
    u64* SSQX = (u64*)(ws + WS_SSQX); u64* SSQX0 = (u64*)(ws + WS_SSQX0); float* SIDE = (float*)(ws + WS_SIDE);
    const float* ROPE = (const float*)(ws + WS_ROPE); float* PART = (float*)(ws + WS_PART); float* CUM = (float*)(ws + WS_CUM); float* KM = (float*)(ws + WS_KM);

    if (IN(0)) {
        LANEVARS();
        LAS float* scr = (LAS float*)(lds + wave * 16640);
        prologue_misc(a, gw, NGW, lane, gtid, NT);
        prologue_weights(a, 0, 2 * TR_LAYER - TR_TAIL, scr, gw, NGW, lane);
        __syncthreads();
    }
    SEAM(0);
    for (int l = 0; l < 2; ++l) {
        const int pb = 1 + 8 * l;
        const unsigned char* wb = ws + WS_W + (size_t)l * WB_LAYER;
        const u64* ssq_in0 = (l == 0) ? SSQX0 : SSQX + 1 * M_TOK;
        u64* ssq_mid = SSQX + (size_t)(2 * l) * M_TOK;
        u64* ssq_end = SSQX + (size_t)(2 * l + 1) * M_TOK;
        u64* ssq_cq = (u64*)(ws + WS_SSQCQ) + (size_t)l * M_TOK; u64* ssq_ckv = (u64*)(ws + WS_SSQCKV) + (size_t)l * M_TOK;
        u64* ssq_y = (u64*)(ws + WS_SSQY) + (size_t)l * M_TOK * 4;
        if (IN(pb + 0)) {
            { pg8::Gemm g{XB, (const bf16*)(wb + WB_IN), M_TOK, 9216, DM, DM, DM, 0}; pg8::StaticOrder S; S.init(M_TOK, 9216, G, bx);
              EpiProj<0> E{PROJ, NINP, ssq_in0, 1.0f / DM, ssq_cq, ssq_ckv, ROPE, nullptr};
              pg8::gemm_phase<EpiProj<0>, pg8::StaticOrder>(lds, g, S, E); }
            for (int su = bx; su < 256; su += G) {
              const int kq = su & 3;
              pg8::Gemm g{XB + kq * 1024, (const bf16*)(wb + WB_IN) + kq * 1024, M_TOK, NINP, 1024, DM, DM, 0}; OneUnit S{su >> 2, 36};
              EpiPart E{PART + (size_t)kq * M_TOK * 72};
              pg8::gemm_phase<EpiPart, OneUnit>(lds, g, S, E); }
        }
        SEAM(pb + 0);
        if (IN(pb + 1)) {
            { pg8::Gemm g{PROJ + 5120, (const bf16*)(wb + WB_UQ), M_TOK, 1536, 768, NINP, 768, 0}; pg8::StaticOrder S; S.init(M_TOK, 1536, G, bx);
              EpiProj<1> E{MLAQ, 1536, ssq_cq, 1.0f / 768.0f, nullptr, nullptr, ROPE, nullptr};
              pg8::gemm_phase<EpiProj<1>, pg8::StaticOrder>(lds, g, S, E); }
            { pg8::Gemm g{PROJ + 5888, (const bf16*)(wb + WB_UKV), M_TOK, 2048, 256, NINP, 256, 0}; pg8::StaticOrder S; S.init(M_TOK, 2048, G, bx);
              EpiProj<2> E{MLAKV, 2048, ssq_ckv, 1.0f / 256.0f, nullptr, nullptr, ROPE, nullptr};
              pg8::gemm_phase<EpiProj<2>, pg8::StaticOrder>(lds, g, S, E); }
            for (int it = vcu; it < 512; it += G) job_kmean(PROJ, KM, it, lds);
            for (int it = vcu; it < 64; it += G) job_cum(PART, ssq_in0, a.in[I_BF] + l * 8, CUM, it, lds);
            { LANEVARS(); job_krope(PART, ssq_in0, ROPE, PROJ, gtid, NT); }
            job_sgu_stream(a, l, vcu, G, 1024, lds);
        }
        SEAM(pb + 1);
        if (IN(pb + 2)) {
            { att::P p{PROJ, NINP, nullptr, 0, PROJ + 1024, NINP, nullptr, 0, PROJ + 2048, NINP, KM, nullptr, Y, ssq_y, 0};
              for (int it = vcu; it < 256; it += G) { const int bh = it >> 2, pr = it & 3;
                  for (int ps = 0; ps < 2; ++ps) att::attn_block<0>(p, bh >> 3, bh & 7, ps ? pr : 7 - pr, lds); } }
            { att::P p{MLAQ, 1536, MLAQ + 1024, 1536, MLAKV, 2048, PROJ + 9216, NINP, MLAKV + 1024, 2048, nullptr, nullptr, Y, ssq_y, 2};
              for (int it = vcu; it < 256; it += G) { const int bh = it >> 2, pr = it & 3;
                  for (int ps = 0; ps < 2; ++ps) att::attn_block<1>(p, bh >> 3, bh & 7, ps ? pr : 7 - pr, lds); } }
            { att::P p{PROJ + 6144, NINP, nullptr, 0, PROJ + 7168, NINP, nullptr, 0, PROJ + 8192, NINP, nullptr, CUM, Y, ssq_y, 3};
              for (int it = vcu; it < 256; it += G) { const int bh = it >> 2, pr = it & 3;
                  for (int ps = 0; ps < 2; ++ps) att::attn_block<2>(p, bh >> 3, bh & 7, ps ? pr : 7 - pr, lds); } }
        }
        SEAM(pb + 2);
        if (IN(pb + 4)) {
            pg8::Gemm g{Y, (const bf16*)(wb + WB_O), M_TOK, DM, DM, DM, DM, 0}; pg8::StaticOrder S; S.init(M_TOK, DM, G, bx);
            unsigned char* xb8 = ((FP8_FFN1 >> l) & 1) ? XB8 : nullptr;
            if (l == 0) { EpiResid<true, true> E{a.in[I_X], XB, ssq_mid, ssq_y, (LAS float*)(lds + XCH_OFF), xb8}; pg8::gemm_phase<EpiResid<true, true>, pg8::StaticOrder>(lds, g, S, E); }
            else { EpiResid<false, true> E{nullptr, XB, ssq_mid, ssq_y, (LAS float*)(lds + XCH_OFF), xb8}; pg8::gemm_phase<EpiResid<false, true>, pg8::StaticOrder>(lds, g, S, E); }
        }
        SEAM(pb + 4);
        if (IN(pb + 5)) {
            pg8::Gemm g{XB, (const bf16*)(wb + WB_GV), M_TOK, NGV, DM, DM, DM, 0}; pg8::StaticOrder S; S.init(M_TOK, NGV, G, bx);
            if ((FP8_FFN1 >> l) & 1) { if constexpr (FP8_FFN1 != 0) {
                pg8::Gemm g8{(const bf16*)XB8, (const bf16*)(wb + WB_GV), M_TOK, NGV, DM / 2, DM / 2, DM / 2, 0};
                EpiFfn1<true, true> E{ACT, ssq_mid, a.in[I_CW] + (size_t)l * 3 * DFF, a.in[I_CB] + (size_t)l * DFF, SIDE, (LAS float*)(lds + XCH_OFF)};
                pg8::gemm_phase<EpiFfn1<true, true>, pg8::StaticOrder>(lds, g8, S, E); } }
            else if ((FP8_LAYERS >> l) & 1) { EpiFfn1<true> E{ACT, ssq_mid, a.in[I_CW] + (size_t)l * 3 * DFF, a.in[I_CB] + (size_t)l * DFF, SIDE, (LAS float*)(lds + XCH_OFF)};
                pg8::gemm_phase<EpiFfn1<true>, pg8::StaticOrder>(lds, g, S, E); }
            else { EpiFfn1<false> E{ACT, ssq_mid, a.in[I_CW] + (size_t)l * 3 * DFF, a.in[I_CB] + (size_t)l * DFF, SIDE, (LAS float*)(lds + XCH_OFF)};
                pg8::gemm_phase<EpiFfn1<false>, pg8::StaticOrder>(lds, g, S, E); }
            if (l == 0) {
                const int nun = (M_TOK / 256) * (NGV / 256), first = nun % G, nw = (first == 0) ? G : G - first;
                if (first == 0 || bx >= first) { LANEVARS(); (void)gw;
                    prologue_weights(a, 2 * TR_LAYER - TR_TAIL, 2 * TR_LAYER, (LAS float*)(lds + wave * 16640), ((first == 0) ? bx : bx - first) * 8 + wave, nw * 8, lane); }
            }
        }
        SEAM(pb + 5);
        if (IN(pb + 6)) { LANEVARS(); job_halo(SIDE, a.in[I_CW] + (size_t)l * 3 * DFF, a.in[I_CB] + (size_t)l * DFF, ACT, gtid, NT, (FP8_LAYERS >> l) & 1); }
        SEAM(pb + 6);
        if (IN(pb + 7)) {
            if ((FP8_LAYERS >> l) & 1) {
            pg8::Gemm g{ACT, (const bf16*)(wb + WB_D), M_TOK, DM, DFF / 2, 64, DFF / 2, 1}; pg8::StaticOrder S; S.init(M_TOK, DM, G, bx, FFN2_WGM);
            EpiResid<false, false, true> E{nullptr, XB, ssq_end, nullptr, nullptr};
            pg8::gemm_phase<EpiResid<false, false, true>, pg8::StaticOrder>(lds, g, S, E);
            } else {
            pg8::Gemm g{ACT, (const bf16*)(wb + WB_D), M_TOK, DM, DFF, 64, DFF, 1}; pg8::StaticOrder S; S.init(M_TOK, DM, G, bx, FFN2_WGM);
            EpiResid<false, false> E{nullptr, XB, ssq_end, nullptr, nullptr};
            pg8::gemm_phase<EpiResid<false, false>, pg8::StaticOrder>(lds, g, S, E);
            }
        }
        SEAM(pb + 7);
    }
    if (IN(17)) { LANEVARS();
        float pscale = 1.0f;
        job_final(a.out, XB, SSQX + 3 * M_TOK, a.in[I_FNG], gw, NGW, lane, pscale);
    }
#undef IN
#undef LANEVARS
#undef SEAM
#undef GRID_BAR
}

extern "C" void kernel_launch(void* const* d_in, const int* in_sizes, int n_in, void* d_out, int out_size, void* d_ws, size_t ws_size, hipStream_t stream) {
    static int grid = 0;
    if (grid == 0) {
        if (n_in != 21 || in_sizes[0] != M_TOK * DM || out_size != M_TOK * DM || ws_size < WS_END) {
            fprintf(stderr, "kernel_launch: unexpected problem (n_in %d, in0 %d, out %d, ws %zu; need ws >= %zu); nothing launched\n", n_in, n_in > 0 ? in_sizes[0] : -1, out_size, ws_size, (size_t)WS_END); grid = -1; return; }
        int dev = 0, cus = 0;
        if (hipGetDevice(&dev) != hipSuccess || hipDeviceGetAttribute(&cus, hipDeviceAttributeMultiprocessorCount, dev) != hipSuccess) { grid = -1; return; }
        if (hipFuncSetAttribute((const void*)hymba_fwd, hipFuncAttributeMaxDynamicSharedMemorySize, LDS_BYTES) != hipSuccess) { fprintf(stderr, "kernel_launch: hipFuncSetAttribute failed\n"); grid = -1; return; }
        int per_cu = 0;
        if (hipOccupancyMaxActiveBlocksPerMultiprocessor(&per_cu, (const void*)hymba_fwd, 512, LDS_BYTES) != hipSuccess || per_cu < 1) fprintf(stderr, "kernel_launch: occupancy query says %d blocks per CU\n", per_cu);
        (void)hipGetLastError();
        grid = cus;
    }
    if (grid < 0) return;
    if (hipMemsetAsync((char*)d_ws + WS_CTL, 0, CTL_ZERO_BYTES, stream) != hipSuccess) return;
    Args a{};
    for (int i = 0; i < 21; ++i) a.in[i] = (const float*)d_in[i];
    a.out = (float*)d_out; a.ws = (unsigned char*)d_ws;
#if MK_MULTI
#ifndef MK_STOP
#define MK_STOP NPHASE
#endif
    for (int ph = 0; ph < MK_STOP; ++ph) { a.ph_lo = ph; a.ph_hi = ph + 1; hipLaunchKernelGGL(hymba_fwd, dim3(grid), dim3(512), LDS_BYTES, stream, a); }
#else
    a.ph_lo = 0; a.ph_hi = NPHASE;
    hipLaunchKernelGGL(hymba_fwd, dim3(grid), dim3(512), LDS_BYTES, stream, a);
#endif
}
```
